# Optimizing an MI355X kernel written in HIP

```python
import math
import jax, jax.numpy as jnp
from jax import lax
import numpy as np

D_MODEL = 2048
BATCH = 2
SEQ = 16384
DEPTH = 2

NORM_EPS = 1e-6
ROPE_THETA = 10000.0
Q_BLOCK = 128
NEG_INF = -1e30
D_FF = 5632
N_BRANCH = 3

MLA_HEADS = 6
MLA_Q_LORA = 768
MLA_KV_LORA = 512
MLA_NOPE = 128
MLA_ROPE = 64
MLA_V = 128
MLA_OUT = MLA_HEADS * MLA_V

NSA_HEADS = 4
NSA_DK = 192
NSA_DV = 128
NSA_CMP_LEN = 32
NSA_CMP_STRIDE = 16
NSA_CMP_HIDDEN = 256
NSA_SEL_LEN = 64
NSA_TOPK = 16
NSA_WINDOW = 512
NSA_FORCE_SCORE = 1e6
NSA_OUT = NSA_HEADS * NSA_DV

DIFF_HEADS = 4
DIFF_HD = 96
DIFF_VD = 2 * DIFF_HD
DIFF_OUT = DIFF_HEADS * DIFF_VD

IN_SPLITS = (
    MLA_Q_LORA, MLA_KV_LORA, MLA_ROPE,
    NSA_HEADS * NSA_DK, NSA_DK, NSA_DV, NSA_DK, NSA_DV, NSA_DK, NSA_DV, NSA_HEADS * 3,
    DIFF_HEADS * 2 * DIFF_HD, DIFF_HEADS * 2 * DIFF_HD, DIFF_HEADS * DIFF_VD,
    N_BRANCH * D_MODEL,
)
D_IN = sum(IN_SPLITS)

kernel_name = "hybrid_mla_nsa_diff_macaron"


def rms_norm(x, w):
    xf = x.astype(jnp.float32)
    y = xf * lax.rsqrt(jnp.mean(xf * xf, axis=-1, keepdims=True) + NORM_EPS)
    return (y * w.astype(jnp.float32)).astype(x.dtype)


def rope_table(dim, seq):
    inv = ROPE_THETA ** (-jnp.arange(0, dim, 2, dtype=jnp.float32) / dim)
    ang = jnp.arange(seq, dtype=jnp.float32)[:, None] * inv[None, :]
    return jnp.cos(ang), jnp.sin(ang)


def apply_rope(x, cos, sin):
    d2 = x.shape[-1] // 2
    x1, x2 = x[..., :d2], x[..., d2:]
    c = cos.astype(x.dtype)
    s = sin.astype(x.dtype)
    return jnp.concatenate([x1 * c - x2 * s, x1 * s + x2 * c], axis=-1)


def swiglu(x, w_in, w_out):
    g, u = jnp.split(x @ w_in, 2, axis=-1)
    return (jax.nn.silu(g) * u) @ w_out


def split_cols(x, sizes):
    offs = np.cumsum(np.array(sizes))[:-1].tolist()
    return jnp.split(x, offs, axis=-1)


def blockwise(block_fn, seq):
    out = lax.map(block_fn, jnp.arange(seq // Q_BLOCK))
    nb, b, qb, w = out.shape
    return jnp.moveaxis(out, 0, 1).reshape(b, nb * qb, w)


def mla_mixer(c_q, c_kv, k_rope, q_norm_w, kv_norm_w, w_uq, w_ukv, cos, sin):
    B, S, _ = c_q.shape
    q = (rms_norm(c_q, q_norm_w) @ w_uq).reshape(B, S, MLA_HEADS, MLA_NOPE + MLA_ROPE).transpose(0, 2, 1, 3)
    q_nope = q[..., :MLA_NOPE]
    q_pe = apply_rope(q[..., MLA_NOPE:], cos, sin)
    kv = (rms_norm(c_kv, kv_norm_w) @ w_ukv).reshape(B, S, MLA_HEADS, MLA_NOPE + MLA_V).transpose(0, 2, 1, 3)
    k_nope, v = kv[..., :MLA_NOPE], kv[..., MLA_NOPE:]
    k_pe = apply_rope(k_rope, cos, sin)
    scale = (MLA_NOPE + MLA_ROPE) ** -0.5
    key_pos = jnp.arange(S)

    def block(i):
        qs = i * Q_BLOCK
        qn = lax.dynamic_slice_in_dim(q_nope, qs, Q_BLOCK, axis=2)
        qp = lax.dynamic_slice_in_dim(q_pe, qs, Q_BLOCK, axis=2)
        s = (jnp.einsum('bhqd,bhkd->bhqk', qn, k_nope)
             + jnp.einsum('bhqd,bkd->bhqk', qp, k_pe)).astype(jnp.float32) * scale
        q_pos = qs + jnp.arange(Q_BLOCK)
        s = jnp.where(key_pos[None, :] <= q_pos[:, None], s, NEG_INF)
        p = jax.nn.softmax(s, axis=-1).astype(v.dtype)
        o = jnp.einsum('bhqk,bhkd->bqhd', p, v)
        return o.reshape(B, Q_BLOCK, MLA_OUT)

    return blockwise(block, S)


def nsa_mixer(q, k_cmp, v_cmp, k_slc, v_slc, k_win, v_win, gate_logits,
              cmp_k_pos, cmp_k_w1, cmp_k_w2, cmp_v_pos, cmp_v_w1, cmp_v_w2, cos, sin):
    B, S, _ = q.shape
    q = apply_rope(q.reshape(B, S, NSA_HEADS, NSA_DK).transpose(0, 2, 1, 3), cos, sin)
    k_cmp = apply_rope(k_cmp, cos, sin)
    k_slc = apply_rope(k_slc, cos, sin)
    k_win = apply_rope(k_win, cos, sin)
    gates = jax.nn.sigmoid(gate_logits.astype(jnp.float32)).astype(q.dtype).reshape(B, S, NSA_HEADS, 3)
    scale = NSA_DK ** -0.5

    n_cmp = (S - NSA_CMP_LEN) // NSA_CMP_STRIDE + 1
    tok = jnp.arange(n_cmp)[:, None] * NSA_CMP_STRIDE + jnp.arange(NSA_CMP_LEN)[None, :]

    def compress(t, pos, w1, w2):
        blk = t[:, tok] + pos
        return jax.nn.silu(blk.reshape(B, n_cmp, -1) @ w1) @ w2

    kc = compress(k_cmp, cmp_k_pos, cmp_k_w1, cmp_k_w2)
    vc = compress(v_cmp, cmp_v_pos, cmp_v_w1, cmp_v_w2)
    cmp_end = jnp.arange(n_cmp) * NSA_CMP_STRIDE + NSA_CMP_LEN - 1

    n_sel = S // NSA_SEL_LEN
    k_top = min(NSA_TOPK, n_sel)
    r_c = NSA_CMP_LEN // NSA_CMP_STRIDE
    ratio = NSA_SEL_LEN // NSA_CMP_STRIDE
    overlap_w = [max(0, min(o * NSA_CMP_STRIDE + NSA_CMP_LEN, NSA_SEL_LEN) - max(o * NSA_CMP_STRIDE, 0)) / NSA_CMP_STRIDE
                 for o in range(-(r_c - 1), ratio)]
    end_pad = n_sel * ratio - n_cmp
    ks_blk = k_slc.reshape(B, n_sel, NSA_SEL_LEN, NSA_DK)
    vs_blk = v_slc.reshape(B, n_sel, NSA_SEL_LEN, NSA_DV)
    blk_ids = jnp.arange(n_sel)

    kw_pad = jnp.pad(k_win, ((0, 0), (NSA_WINDOW, 0), (0, 0)))
    vw_pad = jnp.pad(v_win, ((0, 0), (NSA_WINDOW, 0), (0, 0)))

    def block(i):
        qs = i * Q_BLOCK
        qb = lax.dynamic_slice_in_dim(q, qs, Q_BLOCK, axis=2)
        q_pos = qs + jnp.arange(Q_BLOCK)

        valid_c = cmp_end[None, :] <= q_pos[:, None]
        s_c = jnp.einsum('bhqd,bcd->bhqc', qb, kc).astype(jnp.float32) * scale
        p_c = jax.nn.softmax(jnp.where(valid_c, s_c, NEG_INF), axis=-1) * valid_c
        o_c = jnp.einsum('bhqc,bcd->bhqd', p_c.astype(vc.dtype), vc)

        imp = jnp.pad(p_c.sum(axis=1), ((0, 0), (0, 0), (r_c - 1, end_pad)))
        imp_sel = sum(w_u * imp[..., u:u + n_sel * ratio:ratio] for u, w_u in enumerate(overlap_w))
        cur = q_pos // NSA_SEL_LEN
        forced = (blk_ids[None, :] == 0) | (blk_ids[None, :] == cur[:, None]) | (blk_ids[None, :] == cur[:, None] - 1)
        valid_s = blk_ids[None, :] * NSA_SEL_LEN <= q_pos[:, None]
        imp_sel = jnp.where(valid_s, jnp.where(forced, NSA_FORCE_SCORE, imp_sel), NEG_INF)
        _, idx = lax.top_k(imp_sel, k_top)
        ksel = jax.vmap(lambda kb, ib: kb[ib])(ks_blk, idx).reshape(B, Q_BLOCK, k_top * NSA_SEL_LEN, NSA_DK)
        vsel = jax.vmap(lambda vb, ib: vb[ib])(vs_blk, idx).reshape(B, Q_BLOCK, k_top * NSA_SEL_LEN, NSA_DV)
        sel_pos = (idx[..., None] * NSA_SEL_LEN + jnp.arange(NSA_SEL_LEN)).reshape(B, Q_BLOCK, k_top * NSA_SEL_LEN)
        s_s = jnp.einsum('bhqd,bqkd->bhqk', qb, ksel).astype(jnp.float32) * scale
        s_s = jnp.where((sel_pos <= q_pos[None, :, None])[:, None], s_s, NEG_INF)
        o_s = jnp.einsum('bhqk,bqkd->bhqd', jax.nn.softmax(s_s, axis=-1).astype(vsel.dtype), vsel)

        kw = lax.dynamic_slice_in_dim(kw_pad, qs, Q_BLOCK + NSA_WINDOW, axis=1)
        vw = lax.dynamic_slice_in_dim(vw_pad, qs, Q_BLOCK + NSA_WINDOW, axis=1)
        kpos = qs - NSA_WINDOW + jnp.arange(Q_BLOCK + NSA_WINDOW)
        valid_w = ((kpos[None, :] <= q_pos[:, None]) & (kpos[None, :] > q_pos[:, None] - NSA_WINDOW)
                   & (kpos[None, :] >= 0))
        s_w = jnp.einsum('bhqd,bkd->bhqk', qb, kw).astype(jnp.float32) * scale
        s_w = jnp.where(valid_w, s_w, NEG_INF)
        o_w = jnp.einsum('bhqk,bkd->bhqd', jax.nn.softmax(s_w, axis=-1).astype(vw.dtype), vw)

        g = lax.dynamic_slice_in_dim(gates, qs, Q_BLOCK, axis=1).transpose(0, 2, 1, 3)
        o = g[..., 0:1] * o_c + g[..., 1:2] * o_s + g[..., 2:3] * o_w
        return o.transpose(0, 2, 1, 3).reshape(B, Q_BLOCK, NSA_OUT)

    return blockwise(block, S)


def diff_mixer(q, k, v, lam_q1, lam_k1, lam_q2, lam_k2, subln_w, lambda_init, cos, sin):
    B, S, _ = q.shape
    q = apply_rope(q.reshape(B, S, DIFF_HEADS, 2, DIFF_HD).transpose(0, 2, 3, 1, 4), cos, sin)
    k = apply_rope(k.reshape(B, S, DIFF_HEADS, 2, DIFF_HD).transpose(0, 2, 3, 1, 4), cos, sin)
    v = v.reshape(B, S, DIFF_HEADS, DIFF_VD).transpose(0, 2, 1, 3)
    f32 = jnp.float32
    lam = (jnp.exp(jnp.sum(lam_q1.astype(f32) * lam_k1.astype(f32)))
           - jnp.exp(jnp.sum(lam_q2.astype(f32) * lam_k2.astype(f32))) + lambda_init)
    scale = DIFF_HD ** -0.5
    key_pos = jnp.arange(S)

    def block(i):
        qs = i * Q_BLOCK
        qb = lax.dynamic_slice_in_dim(q, qs, Q_BLOCK, axis=3)
        s = jnp.einsum('bhmqd,bhmkd->bhmqk', qb, k).astype(f32) * scale
        q_pos = qs + jnp.arange(Q_BLOCK)
        p = jax.nn.softmax(jnp.where(key_pos[None, :] <= q_pos[:, None], s, NEG_INF), axis=-1)
        a = p[:, :, 0] - lam * p[:, :, 1]
        o = jnp.einsum('bhqk,bhkd->bqhd', a.astype(v.dtype), v)
        o = rms_norm(o, subln_w) * (1.0 - lambda_init)
        return o.reshape(B, Q_BLOCK, DIFF_OUT)

    return blockwise(block, S)


def setup_inputs(seed: int = 0) -> dict:
    key = jax.random.key(seed)
    ks = iter(jax.random.split(key, 32))
    L = DEPTH

    def w(shape, fan_in):
        return jax.random.normal(next(ks), shape, jnp.float32) * fan_in ** -0.5

    def gain(shape):
        return 1.0 + 0.01 * jax.random.normal(next(ks), shape, jnp.float32)

    def small(shape, s):
        return s * jax.random.normal(next(ks), shape, jnp.float32)

    return {
        "x": jax.random.normal(next(ks), (BATCH, SEQ, D_MODEL), jnp.float32),
        "ffn1_norm": gain((L, D_MODEL)),
        "ffn1_w_in": w((L, D_MODEL, 2 * D_FF), D_MODEL),
        "ffn1_w_out": w((L, D_FF, D_MODEL), D_FF),
        "mix_norm": gain((L, D_MODEL)),
        "w_in": w((L, D_MODEL, D_IN), D_MODEL),
        "mla_q_norm": gain((L, MLA_Q_LORA)),
        "mla_kv_norm": gain((L, MLA_KV_LORA)),
        "mla_w_uq": w((L, MLA_Q_LORA, MLA_HEADS * (MLA_NOPE + MLA_ROPE)), MLA_Q_LORA),
        "mla_w_ukv": w((L, MLA_KV_LORA, MLA_HEADS * (MLA_NOPE + MLA_V)), MLA_KV_LORA),
        "nsa_cmp_k_pos": small((L, NSA_CMP_LEN, NSA_DK), 0.1),
        "nsa_cmp_k_w1": w((L, NSA_CMP_LEN * NSA_DK, NSA_CMP_HIDDEN), NSA_CMP_LEN * NSA_DK),
        "nsa_cmp_k_w2": w((L, NSA_CMP_HIDDEN, NSA_DK), NSA_CMP_HIDDEN),
        "nsa_cmp_v_pos": small((L, NSA_CMP_LEN, NSA_DV), 0.1),
        "nsa_cmp_v_w1": w((L, NSA_CMP_LEN * NSA_DV, NSA_CMP_HIDDEN), NSA_CMP_LEN * NSA_DV),
        "nsa_cmp_v_w2": w((L, NSA_CMP_HIDDEN, NSA_DV), NSA_CMP_HIDDEN),
        "diff_lam_q1": small((L, DIFF_HD), 0.1),
        "diff_lam_k1": small((L, DIFF_HD), 0.1),
        "diff_lam_q2": small((L, DIFF_HD), 0.1),
        "diff_lam_k2": small((L, DIFF_HD), 0.1),
        "diff_subln": gain((L, DIFF_VD)),
        "w_br_mla": w((L, MLA_OUT, D_MODEL), MLA_OUT),
        "w_br_nsa": w((L, NSA_OUT, D_MODEL), NSA_OUT),
        "w_br_diff": w((L, DIFF_OUT, D_MODEL), DIFF_OUT),
        "w_out": w((L, D_MODEL, D_MODEL), D_MODEL),
        "ffn2_norm": gain((L, D_MODEL)),
        "ffn2_w_in": w((L, D_MODEL, 2 * D_FF), D_MODEL),
        "ffn2_w_out": w((L, D_FF, D_MODEL), D_FF),
        "final_norm": gain((D_MODEL,)),
    }


def reference(x, ffn1_norm, ffn1_w_in, ffn1_w_out, mix_norm, w_in, mla_q_norm, mla_kv_norm,
              mla_w_uq, mla_w_ukv, nsa_cmp_k_pos, nsa_cmp_k_w1, nsa_cmp_k_w2, nsa_cmp_v_pos,
              nsa_cmp_v_w1, nsa_cmp_v_w2, diff_lam_q1, diff_lam_k1, diff_lam_q2, diff_lam_k2,
              diff_subln, w_br_mla, w_br_nsa, w_br_diff, w_out, ffn2_norm, ffn2_w_in, ffn2_w_out,
              final_norm):
    B, S, _ = x.shape
    cos_mla, sin_mla = rope_table(MLA_ROPE, S)
    cos_nsa, sin_nsa = rope_table(NSA_DK, S)
    cos_diff, sin_diff = rope_table(DIFF_HD, S)

    for l in range(DEPTH):
        x = x + 0.5 * swiglu(rms_norm(x, ffn1_norm[l]), ffn1_w_in[l], ffn1_w_out[l])

        n = rms_norm(x, mix_norm[l])
        (c_q, c_kv, k_rope, nsa_q, nsa_kc, nsa_vc, nsa_ks, nsa_vs, nsa_kw, nsa_vw, nsa_g,
         d_q, d_k, d_v, merge_logits) = split_cols(n @ w_in[l], IN_SPLITS)

        o_mla = mla_mixer(c_q, c_kv, k_rope, mla_q_norm[l], mla_kv_norm[l], mla_w_uq[l], mla_w_ukv[l],
                          cos_mla, sin_mla)
        o_nsa = nsa_mixer(nsa_q, nsa_kc, nsa_vc, nsa_ks, nsa_vs, nsa_kw, nsa_vw, nsa_g,
                          nsa_cmp_k_pos[l], nsa_cmp_k_w1[l], nsa_cmp_k_w2[l],
                          nsa_cmp_v_pos[l], nsa_cmp_v_w1[l], nsa_cmp_v_w2[l], cos_nsa, sin_nsa)
        lambda_init = 0.8 - 0.6 * math.exp(-0.3 * l)
        o_diff = diff_mixer(d_q, d_k, d_v, diff_lam_q1[l], diff_lam_k1[l], diff_lam_q2[l], diff_lam_k2[l],
                            diff_subln[l], lambda_init, cos_diff, sin_diff)

        g = jax.nn.sigmoid(merge_logits.astype(jnp.float32)).astype(x.dtype).reshape(B, S, N_BRANCH, D_MODEL)
        mixed = (g[:, :, 0] * (o_mla @ w_br_mla[l])
                 + g[:, :, 1] * (o_nsa @ w_br_nsa[l])
                 + g[:, :, 2] * (o_diff @ w_br_diff[l]))
        x = x + mixed @ w_out[l]

        x = x + 0.5 * swiglu(rms_norm(x, ffn2_norm[l]), ffn2_w_in[l], ffn2_w_out[l])

    return rms_norm(x, final_norm)
```

```cpp
#include <hip/hip_runtime.h>
#include <cstdio>
#include <cstdint>

#define GAS __attribute__((address_space(1)))
#define LAS __attribute__((address_space(3)))
typedef unsigned short bf16_t;
typedef short bf16x8 __attribute__((ext_vector_type(8)));
typedef short s16x4 __attribute__((ext_vector_type(4)));
typedef float f32x4 __attribute__((ext_vector_type(4)));
typedef float f32x16 __attribute__((ext_vector_type(16)));
typedef unsigned u32x4 __attribute__((ext_vector_type(4)));
typedef unsigned u32x2 __attribute__((ext_vector_type(2)));
typedef unsigned long long u64;
constexpr float STAT_FIX = 4294967296.0f;

#ifndef REP2_MASK
#define REP2_MASK 7
#endif
#ifndef DUPMASK
#define DUPMASK 0u
#endif
#ifndef MK_SPLIT
#define MK_SPLIT 0
#endif

constexpr int D = 2048, SEQ = 16384, BATCH = 2, T = BATCH * SEQ, DFF = 5632, DIN = 11532, DEPTH = 2;
constexpr int NPROJ = 5632;
constexpr float EPS = 1e-6f;
constexpr float QS192 = 0.10411754627697264f;
constexpr float QS96 = 0.14724444602590306f;
constexpr float LOG2E = 1.4426950408889634f;
constexpr int NTAB = 176;

constexpr size_t MiB = 1u << 20;
constexpr size_t WS_CTL = 0, CTL_BYTES = 1 * MiB;
constexpr size_t WS_BIASP = 1 * MiB;
constexpr size_t WS_ROPE = 2 * MiB;
constexpr size_t WS_W = 24 * MiB;
constexpr size_t W_FFN_IN = WS_W, W_FFN_OUT = W_FFN_IN + 44 * MiB, W_PROJ = W_FFN_OUT + 22 * MiB, W_GATE = W_PROJ + 22 * MiB,
                 W_UQ = W_GATE + 24 * MiB, W_UKV = W_UQ + 2 * MiB, W_CK1 = W_UKV + 2 * MiB, W_CV1 = W_CK1 + 3 * MiB, W_CK2 = W_CV1 + 2 * MiB,
                 W_CV2 = W_CK2 + (MiB / 2), W_BRM = W_CV2 + (MiB / 2), W_BRN = W_BRM + 3 * MiB, W_BRD = W_BRN + 2 * MiB, W_OUT = W_BRD + 3 * MiB,
                 WS_WEND = W_OUT + 8 * MiB;
constexpr size_t WS_NBUF = WS_WEND;
constexpr size_t WS_BIG = WS_NBUF + 128 * MiB;
constexpr size_t B_ACT = WS_BIG;
constexpr size_t B_CQ = WS_BIG, B_CKV = B_CQ + 48 * MiB;
constexpr size_t B_OMLA = WS_BIG, B_ONSA = B_OMLA + 48 * MiB, B_ODIFF = B_ONSA + 32 * MiB;
constexpr size_t B_QM = WS_BIG + 128 * MiB, B_KM = B_QM + 72 * MiB, B_VM = B_KM + 72 * MiB, B_NQ = B_VM + 48 * MiB,
                 B_KCMP = B_NQ + 48 * MiB, B_VCMP = B_KCMP + 13 * MiB, B_KSLC = B_VCMP + 9 * MiB, B_VSLC = B_KSLC + 12 * MiB,
                 B_KWIN = B_VSLC + 8 * MiB, B_VWIN = B_KWIN + 12 * MiB, B_NGATE = B_VWIN + 8 * MiB, B_DQ = B_NGATE + 2 * MiB,
                 B_DK = B_DQ + 48 * MiB, B_DV = B_DK + 48 * MiB, B_HIDK = B_DV + 48 * MiB, B_HIDV = B_HIDK + 1 * MiB,
                 B_KC = B_HIDV + 1 * MiB, B_VC = B_KC + 1 * MiB, B_END = B_VC + 1 * MiB;
constexpr size_t WS_STATS = B_END;
constexpr size_t WS_MIXB = WS_STATS + 2 * MiB;
constexpr size_t B_G = B_QM;
static_assert(B_G + 384 * MiB <= B_END + 64 * MiB, "G overlay");
constexpr size_t WS_END = WS_MIXB + 128 * MiB;
static_assert(B_END >= B_ACT + 352 * MiB && B_END >= B_G + 384 * MiB, "workspace map");
constexpr int CW_BAR = 0;
constexpr int CW_Q = 4096;
constexpr int CW_EXIT = 8192;
constexpr int CTL_WORDS = 8256;
__device__ unsigned g_ctl[CTL_WORDS];

constexpr int LDS_BYTES = 163840;
constexpr int RING_BYTES = 131072;
constexpr int NSA_STRIP_OFF = 116736, NSA_SEL_OFF = 134144, NSA_UNI_OFF = 136192;
constexpr int NSA_URB_OFF = 136448;
constexpr int NSA_IMP_OFF = 51200;
constexpr int MISC_OFF = 163840 - 256;

typedef float f32x2_t __attribute__((ext_vector_type(2)));
typedef __bf16 bf16x2_t __attribute__((ext_vector_type(2)));
__device__ __forceinline__ unsigned cvt_pk_bf16(float lo, float hi) { const f32x2_t v = {lo, hi}; const bf16x2_t b = __builtin_convertvector(v, bf16x2_t); return __builtin_bit_cast(unsigned, b); }
__device__ __forceinline__ u32x4 pack8f(f32x4 a, f32x4 b) { u32x4 w; w.x = cvt_pk_bf16(a[0], a[1]); w.y = cvt_pk_bf16(a[2], a[3]); w.z = cvt_pk_bf16(b[0], b[1]); w.w = cvt_pk_bf16(b[2], b[3]); return w; }
__device__ __forceinline__ float bf_lo(unsigned u) { return __uint_as_float(u << 16); }
__device__ __forceinline__ float bf_hi(unsigned u) { return __uint_as_float(u & 0xffff0000u); }
__device__ __forceinline__ float wave_sum(float v) {
#pragma unroll
    for (int o = 1; o < 64; o <<= 1) v += __shfl_xor(v, o);
    return v;
}
__device__ __forceinline__ int opaque_tid() { int t = threadIdx.x; asm volatile("" : "+v"(t)); return t; }
__device__ __forceinline__ float fast_sigmoid(float x) { return __builtin_amdgcn_rcpf(1.0f + __builtin_amdgcn_exp2f(-x * LOG2E)); }

#define XB_TMO      128
#define XB_XCNT(j)  (256  + 64 * (j))
#define XB_XSUB(j)  (1280 + 64 * (j))
#define XB_XGEN(j)  (2304 + 64 * (j))
#define XB_TOP      3328
#define XB_TOPGEN   3392
#define XCD_BAR_WORDS 3456
#define XB_SPIN_CAP (1u << 22)
__device__ __forceinline__ unsigned xb_ld(unsigned* p)              { return __hip_atomic_load(p, __ATOMIC_RELAXED, __HIP_MEMORY_SCOPE_AGENT); }
__device__ __forceinline__ unsigned xb_add(unsigned* p, unsigned v) { return __hip_atomic_fetch_add(p, v, __ATOMIC_RELAXED, __HIP_MEMORY_SCOPE_AGENT); }
__device__ __forceinline__ unsigned xb_xcc_id() { return (unsigned)__builtin_amdgcn_s_getreg((3 << 11) | 20) & 0xFu; }
#define XB_SPIN(cond, bar) do { unsigned _sp = 0; while (cond) { __builtin_amdgcn_s_sleep(1); \
    if ((++_sp & 255u) == 0u) { if (xb_ld(&(bar)[XB_TMO])) break; if (_sp > XB_SPIN_CAP) { atomicAdd(&(bar)[XB_TMO], 1u); break; } } } } while (0)
struct XcdBarrier { unsigned* bar; unsigned x; volatile LAS unsigned* st; };
__device__ __forceinline__ XcdBarrier xcd_barrier_post(unsigned* bar, volatile LAS unsigned* st) {
    XcdBarrier b; b.bar = bar; b.x = xb_xcc_id(); b.st = st;
    if (threadIdx.x == 0) (void)xb_add(&bar[XB_XCNT(b.x)], 1u);
    return b;
}
__device__ __forceinline__ void xcd_barrier_complete(unsigned* bar, unsigned x, unsigned& nloc, unsigned& nx) {
    const unsigned G = gridDim.x * gridDim.y * gridDim.z;
    unsigned sum, cnt, mine, sp = 0u;
    for (;;) {
        sum = 0u; cnt = 0u; mine = 0u;
#pragma unroll
        for (unsigned j = 0; j < 16; ++j) { const unsigned c = xb_ld(&bar[XB_XCNT(j)]); sum += c; cnt += (c > 0u) ? 1u : 0u; mine = (j == x) ? c : mine; }
        if (sum == G) break;
        __builtin_amdgcn_s_sleep(1);
        if ((++sp & 255u) == 0u) { if (xb_ld(&bar[XB_TMO])) break; if (sp > XB_SPIN_CAP) { atomicAdd(&bar[XB_TMO], 1u); break; } }
    }
    nloc = mine > 0u ? mine : 1u; nx = cnt > 0u ? cnt : 1u;
}
__device__ __forceinline__ void xcd_barrier(const XcdBarrier& b) {
    asm volatile("s_waitcnt vmcnt(0)" ::: "memory");
    __syncthreads();
    if (threadIdx.x == 0) {
        unsigned* bar = b.bar;
        __builtin_amdgcn_s_waitcnt(0);
        unsigned nloc = b.st[0], nx = b.st[1];
        if (nloc == 0u) { xcd_barrier_complete(bar, b.x, nloc, nx); b.st[0] = nloc; b.st[1] = nx; }
        const unsigned old = xb_add(&bar[XB_XSUB(b.x)], 1u);
        const unsigned gen = old / nloc;
        if (old + 1u == (gen + 1u) * nloc) {
            __builtin_amdgcn_fence(__ATOMIC_RELEASE, "agent");
            asm volatile("s_waitcnt vmcnt(0)" ::: "memory");
            const unsigned og = xb_add(&bar[XB_TOP], 1u);
            const unsigned tg = og / nx;
            if (og + 1u == (tg + 1u) * nx) xb_add(&bar[XB_TOPGEN], 1u);
            else XB_SPIN(xb_ld(&bar[XB_TOPGEN]) == tg, bar);
            __builtin_amdgcn_fence(__ATOMIC_ACQUIRE, "agent");
            xb_add(&bar[XB_XGEN(b.x)], 1u);
            asm volatile("s_waitcnt vmcnt(0)" ::: "memory");
        } else {
            XB_SPIN(xb_ld(&bar[XB_XGEN(b.x)]) == gen, bar);
            __builtin_amdgcn_fence(__ATOMIC_ACQUIRE, "agent");
            asm volatile("s_waitcnt vmcnt(0)" ::: "memory");
        }
    }
    __syncthreads();
}

namespace pg8 {
constexpr int BM = 256, BK = 64, HALF = 128, HTB = HALF * BK * 2, STAGE_BYTES = 8 * HTB, NXCD = 8, WGM = 4;
__host__ __device__ __forceinline__ int lds_byte(int r, int c) { const int st = (r >> 4) * 2 + (c >> 5), rr = r & 15, cc = c & 31, ob = rr * 64 + cc * 2; return st * 1024 + (ob ^ (((ob >> 9) & 1) << 5)); }
__host__ __device__ __forceinline__ void stage_rc(int b, int& R, int& C) { const int st = b / 1024, sb = b % 1024, swz = sb ^ (((sb >> 9) & 1) << 5); R = (st >> 1) * 16 + swz / 64; C = (st & 1) * 32 + (swz % 64) / 2; }
__host__ __device__ __forceinline__ int perm32(int rho) { const int n = rho >> 4, i = rho & 15; return 8 * (i >> 2) + 4 * n + (i & 3); }
struct Unit { int pm, pn; };
struct Gemm { const bf16_t* A; const bf16_t* Bt; int M, N, K, lda, ldb; };
struct StaticOrder {
    int nM, nN, nwg, G, c;
    __host__ __device__ void init(int M, int N, int G_, int c_) { nM = M / BM; nN = N / BM; nwg = nM * nN; G = G_; c = c_; }
    __host__ __device__ bool next(int i, Unit& u) const {
        const long L = (long)i * G + c; if (L >= nwg) return false;
        int wgid = (int)L; { const int q = nwg / NXCD, r = nwg % NXCD, xcd = wgid % NXCD, off = wgid / NXCD; wgid = (xcd < r ? xcd * (q + 1) : r * (q + 1) + (xcd - r) * q) + off; }
        const int nig = WGM * nN, gid = wgid / nig, fm = gid * WGM, gsz = (nM - fm) < WGM ? (nM - fm) : WGM;
        u.pm = fm + ((wgid % nig) % gsz); u.pn = (wgid % nig) / gsz; return true;
    }
    __device__ __forceinline__ void a_ready(const Unit&) const {}
    __device__ __forceinline__ void done(const Unit&) const {}
};
template <class Epi, class Sched, bool ALIGN_EPI = true, bool SP2 = true>
__device__ __forceinline__ void gemm_phase(LAS unsigned char* lds, const Gemm g, const Sched& S, const Epi& E) {
    const int tid = opaque_tid(), wid = __builtin_amdgcn_readfirstlane(tid >> 6), lane = tid & 63, wr = wid >> 2, wc = wid & 3, fr = lane & 15, fq = lane >> 4;
    const int K = g.K, nt = K / BK;
    unsigned voffA[2], voffB[2];
#pragma unroll
    for (int i = 0; i < 2; ++i) { int R, C; stage_rc(tid * 16 + i * 8192, R, C); const int Rb = Epi::PERM ? ((R & ~31) + perm32(R & 31)) : R;
        voffA[i] = (unsigned)(R * g.lda + C) * 2u; voffB[i] = (unsigned)(Rb * g.ldb + C) * 2u; }
    const size_t kstep = (size_t)(BK * 2);
    const size_t hstepA = (size_t)HALF * g.lda * 2, hstepB = (size_t)HALF * g.ldb * 2;
    const size_t tstepA = 2 * hstepA, tstepB = 2 * hstepB;
    const unsigned ldsw = (unsigned)wid * 1024u;
    const int aoff = lds_byte(wr * 64 + fr, fq * 8), boff = lds_byte(wc * 32 + fr, fq * 8);
#define PG8_SA(b, h) (((b) * 2 + (h)) * HTB)
#define PG8_SB(b, h) ((4 + (b) * 2 + (h)) * HTB)
#define PG8_STAGE(bufoff, gbase, voff) do { _Pragma("unroll") for (int _i = 0; _i < 2; ++_i) \
        __builtin_amdgcn_global_load_lds((const unsigned*)((const char*)(gbase) + (voff)[_i]), (LAS unsigned*)(lds + (bufoff) + ldsw + _i * 8192), 16, 0, 0); } while (0)
#define PG8_LDA(dst, b, h) do { _Pragma("unroll") for (int m = 0; m < 4; ++m) _Pragma("unroll") for (int k = 0; k < 2; ++k) dst[m][k] = *(const LAS bf16x8*)(lds + PG8_SA(b, h) + aoff + m * 2048 + k * 1024); } while (0)
#define PG8_LDB(dst, b, h) do { _Pragma("unroll") for (int n = 0; n < 2; ++n) _Pragma("unroll") for (int k = 0; k < 2; ++k) dst[n][k] = *(const LAS bf16x8*)(lds + PG8_SB(b, h) + boff + n * 2048 + k * 1024); } while (0)
#define PG8_MMA(ai, bj, At, Bt) do { __builtin_amdgcn_s_setprio(1); _Pragma("unroll") for (int m = 0; m < 4; ++m) _Pragma("unroll") for (int n = 0; n < 2; ++n) _Pragma("unroll") for (int k = 0; k < 2; ++k) \
        acc[ai][bj][m][n] = __builtin_amdgcn_mfma_f32_16x16x32_bf16(Bt[n][k], At[m][k], acc[ai][bj][m][n], 0, 0, 0); __builtin_amdgcn_s_setprio(0); } while (0)
#define PG8_WAIT_V(n) asm volatile("s_waitcnt vmcnt(" #n ")" ::: "memory")
#define PG8_WAIT_L(n) asm volatile("s_waitcnt lgkmcnt(" #n ")" ::: "memory")
#define PG8_BAR __builtin_amdgcn_s_barrier()
#define PG8_SCHED __builtin_amdgcn_sched_barrier(0)
    Unit cur, nxt; int ui = 0;
    if (!S.next(0, cur)) return;
    f32x4 acc[2][2][4][2];
#pragma unroll
    for (int a = 0; a < 2; ++a)
#pragma unroll
        for (int b = 0; b < 2; ++b)
#pragma unroll
            for (int m = 0; m < 4; ++m)
#pragma unroll
                for (int n = 0; n < 2; ++n) acc[a][b][m][n] = (f32x4){0.f, 0.f, 0.f, 0.f};
    bf16x8 At[4][2], B0[2][2], B1[2][2];
    const char* cA = (const char*)g.A + (size_t)cur.pm * tstepA; const char* cB = (const char*)g.Bt + (size_t)cur.pn * tstepB;
    S.a_ready(cur);
    if constexpr (SP2) {
        PG8_STAGE(PG8_SB(0, 0), cB, voffB); PG8_STAGE(PG8_SB(0, 1), cB + hstepB, voffB); PG8_STAGE(PG8_SA(0, 0), cA, voffA); PG8_STAGE(PG8_SA(0, 1), cA + hstepA, voffA);
        if (wr == 1) PG8_BAR;
        PG8_WAIT_V(2); PG8_BAR;
        PG8_STAGE(PG8_SB(1, 0), cB + kstep, voffB); PG8_STAGE(PG8_SA(1, 0), cA + kstep, voffA); PG8_STAGE(PG8_SB(1, 1), cB + hstepB + kstep, voffB);
        PG8_WAIT_V(6); PG8_BAR;
    } else {
        PG8_STAGE(PG8_SB(0, 0), cB, voffB); PG8_STAGE(PG8_SA(0, 0), cA, voffA); PG8_STAGE(PG8_SB(0, 1), cB + hstepB, voffB); PG8_STAGE(PG8_SA(0, 1), cA + hstepA, voffA);
        if (wr == 1) PG8_BAR;
        PG8_WAIT_V(4); PG8_BAR;
        PG8_STAGE(PG8_SB(1, 0), cB + kstep, voffB); PG8_STAGE(PG8_SA(1, 0), cA + kstep, voffA); PG8_STAGE(PG8_SB(1, 1), cB + hstepB + kstep, voffB);
        PG8_WAIT_V(6); PG8_BAR;
    }
    for (;;) {
        const bool has_next = S.next(ui + 1, nxt);
        const char* nA = has_next ? (const char*)g.A + (size_t)nxt.pm * tstepA : cA; const char* nB = has_next ? (const char*)g.Bt + (size_t)nxt.pn * tstepB : cB;
#pragma unroll 1
        for (int t = 0; t < nt; t += 2) {
            const bool last = (t == nt - 2);
            const char* a1 = cA + (size_t)(t + 1) * kstep;
            const char* a2 = last ? nA : cA + (size_t)(t + 2) * kstep; const char* b2 = last ? nB : cB + (size_t)(t + 2) * kstep;
            const char* a3 = a2 + kstep; const char* b3 = b2 + kstep;
            if (last && has_next) S.a_ready(nxt);
            if constexpr (SP2) {
            PG8_LDB(B0, 0, 0); PG8_LDB(B1, 0, 1); PG8_SCHED; PG8_LDA(At, 0, 0); PG8_STAGE(PG8_SA(1, 1), a1 + hstepA, voffA);
            PG8_WAIT_V(8); PG8_WAIT_L(0); PG8_BAR; PG8_MMA(0, 0, At, B0); PG8_MMA(0, 1, At, B1); PG8_BAR; PG8_SCHED;
            PG8_LDA(At, 0, 1); PG8_STAGE(PG8_SB(0, 0), b2, voffB); PG8_STAGE(PG8_SB(0, 1), b2 + hstepB, voffB); PG8_STAGE(PG8_SA(0, 0), a2, voffA);
            PG8_WAIT_V(8); PG8_WAIT_L(0); PG8_BAR; PG8_MMA(1, 0, At, B0); PG8_MMA(1, 1, At, B1); PG8_BAR; PG8_SCHED;
            PG8_LDB(B0, 1, 0); PG8_LDB(B1, 1, 1); PG8_SCHED; PG8_LDA(At, 1, 0); PG8_STAGE(PG8_SA(0, 1), a2 + hstepA, voffA);
            PG8_WAIT_V(8); PG8_WAIT_L(0); PG8_BAR; PG8_MMA(0, 0, At, B0); PG8_MMA(0, 1, At, B1); PG8_BAR; PG8_SCHED;
            PG8_LDA(At, 1, 1); PG8_STAGE(PG8_SB(1, 0), b3, voffB); PG8_STAGE(PG8_SB(1, 1), b3 + hstepB, voffB); PG8_STAGE(PG8_SA(1, 0), a3, voffA);
            PG8_WAIT_V(8); PG8_WAIT_L(0); PG8_BAR; PG8_MMA(1, 0, At, B0); PG8_MMA(1, 1, At, B1); PG8_BAR; PG8_SCHED;
            } else {
            PG8_LDB(B0, 0, 0); PG8_SCHED; PG8_LDA(At, 0, 0); PG8_STAGE(PG8_SA(1, 1), a1 + hstepA, voffA);
            PG8_WAIT_L(8); PG8_BAR; PG8_WAIT_L(0); PG8_MMA(0, 0, At, B0); PG8_BAR; PG8_SCHED;
            PG8_LDB(B1, 0, 1); PG8_STAGE(PG8_SB(0, 0), b2, voffB);
            PG8_BAR; PG8_WAIT_L(0); PG8_MMA(0, 1, At, B1); PG8_BAR;
            PG8_LDA(At, 0, 1); PG8_STAGE(PG8_SA(0, 0), a2, voffA);
            PG8_BAR; PG8_WAIT_L(0); PG8_MMA(1, 0, At, B0); PG8_BAR; PG8_SCHED;
            PG8_STAGE(PG8_SB(0, 1), b2 + hstepB, voffB);
            PG8_WAIT_V(6); PG8_BAR; PG8_MMA(1, 1, At, B1); PG8_BAR;
            PG8_LDB(B0, 1, 0); PG8_SCHED; PG8_LDA(At, 1, 0); PG8_STAGE(PG8_SA(0, 1), a2 + hstepA, voffA);
            PG8_WAIT_L(8); PG8_BAR; PG8_WAIT_L(0); PG8_MMA(0, 0, At, B0); PG8_BAR; PG8_SCHED;
            PG8_LDB(B1, 1, 1); PG8_STAGE(PG8_SB(1, 0), b3, voffB);
            PG8_BAR; PG8_WAIT_L(0); PG8_MMA(0, 1, At, B1); PG8_BAR;
            PG8_LDA(At, 1, 1); PG8_STAGE(PG8_SA(1, 0), a3, voffA);
            PG8_BAR; PG8_WAIT_L(0); PG8_MMA(1, 0, At, B0); PG8_BAR; PG8_SCHED;
            PG8_STAGE(PG8_SB(1, 1), b3 + hstepB, voffB);
            PG8_WAIT_V(6); PG8_BAR; PG8_MMA(1, 1, At, B1); PG8_BAR;
            }
        }
        if constexpr (ALIGN_EPI) { if (wr == 0) PG8_BAR; }
        E(acc, cur, wr, wc, fr, fq); S.done(cur);
        if (!has_next) break;
#pragma unroll
        for (int a = 0; a < 2; ++a)
#pragma unroll
            for (int b = 0; b < 2; ++b)
#pragma unroll
                for (int m = 0; m < 4; ++m)
#pragma unroll
                    for (int n = 0; n < 2; ++n) acc[a][b][m][n] = (f32x4){0.f, 0.f, 0.f, 0.f};
        cur = nxt; cA = nA; cB = nB; ++ui;
        if constexpr (ALIGN_EPI) { if (wr == 1) PG8_BAR; }
    }
    PG8_WAIT_V(0);
    if constexpr (!ALIGN_EPI) { if (wr == 0) PG8_BAR; }
    PG8_BAR;
#undef PG8_SA
#undef PG8_SB
#undef PG8_STAGE
#undef PG8_LDA
#undef PG8_LDB
#undef PG8_MMA
#undef PG8_WAIT_V
#undef PG8_WAIT_L
#undef PG8_BAR
#undef PG8_SCHED
}
}
using pg8::Unit;

__device__ __forceinline__ float rstd_of(const u64* st, int row) { return 1.0f / sqrtf((float)st[row] * (1.0f / (STAT_FIX * (float)D)) + EPS); }
#define EPI_ROWS_BEGIN _Pragma("unroll") for (int ai = 0; ai < 2; ++ai) _Pragma("unroll") for (int m = 0; m < 4; ++m) { const int row = u.pm * 256 + ai * 128 + wr * 64 + m * 16 + fr;
#define EPI_ROWS_END }
#define EPI_LOAD_RSTD(rsv, stp) float rsv[2][4]; { u64 sv_[2][4]; \
    _Pragma("unroll") for (int ai = 0; ai < 2; ++ai) _Pragma("unroll") for (int m = 0; m < 4; ++m) sv_[ai][m] = ((const GAS u64*)(stp))[u.pm * 256 + ai * 128 + wr * 64 + m * 16 + fr]; \
    _Pragma("unroll") for (int ai = 0; ai < 2; ++ai) _Pragma("unroll") for (int m = 0; m < 4; ++m) rsv[ai][m] = __builtin_amdgcn_rsqf((float)sv_[ai][m] * (1.0f / (STAT_FIX * (float)D)) + EPS); }

struct EpiSwiglu {
    static constexpr bool PERM = true;
    bf16_t* O; int ldc; const u64* st;
    __device__ __forceinline__ void operator()(const f32x4 (&acc)[2][2][4][2], const Unit& u, int wr, int wc, int fr, int fq) const {
        const int col = u.pn * 128 + wc * 32 + 8 * fq;
        EPI_LOAD_RSTD(rsv, st)
        EPI_ROWS_BEGIN
            const float rs = rsv[ai][m], kneg = -rs * LOG2E, cinv = __builtin_amdgcn_rcpf(rs * rs);
            f32x4 a0, a1;
#pragma unroll
            for (int e = 0; e < 4; ++e) { const float g0 = acc[ai][0][m][0][e], g1 = acc[ai][0][m][1][e];
                const float e0 = __builtin_amdgcn_exp2f(g0 * kneg), e1 = __builtin_amdgcn_exp2f(g1 * kneg);
                a0[e] = (g0 * acc[ai][1][m][0][e]) * __builtin_amdgcn_rcpf(__builtin_fmaf(e0, cinv, cinv)); a1[e] = (g1 * acc[ai][1][m][1][e]) * __builtin_amdgcn_rcpf(__builtin_fmaf(e1, cinv, cinv)); }
            __builtin_nontemporal_store(pack8f(a0, a1), (GAS u32x4*)((GAS bf16_t*)O + (size_t)row * ldc + col));
        EPI_ROWS_END
    }
};
struct EpiResid {
    static constexpr bool PERM = true;
    bf16_t* xb; float alpha; u64* st;
    __device__ __forceinline__ void operator()(const f32x4 (&acc)[2][2][4][2], const Unit& u, int wr, int wc, int fr, int fq) const {
        const bool do_st = (st != nullptr);
        u32x4 b[2][4][2];
#pragma unroll
        for (int ai = 0; ai < 2; ++ai)
#pragma unroll
            for (int m = 0; m < 4; ++m)
#pragma unroll
                for (int bj = 0; bj < 2; ++bj) { const size_t off = (size_t)(u.pm * 256 + ai * 128 + wr * 64 + m * 16 + fr) * D + u.pn * 256 + bj * 128 + wc * 32 + 8 * fq;
                    b[ai][m][bj] = *(const GAS u32x4*)((const GAS bf16_t*)xb + off); }
#pragma unroll
        for (int ai = 0; ai < 2; ++ai) {
#pragma unroll
            for (int m = 0; m < 4; ++m) { const int row = u.pm * 256 + ai * 128 + wr * 64 + m * 16 + fr; float q = 0.f;
#pragma unroll
                for (int bj = 0; bj < 2; ++bj) { const size_t off = (size_t)row * D + u.pn * 256 + bj * 128 + wc * 32 + 8 * fq;
                    const u32x4 o = b[ai][m][bj]; f32x4 x0, x1;
                    x0[0] = bf_lo(o.x) + acc[ai][bj][m][0][0] * alpha; x0[1] = bf_hi(o.x) + acc[ai][bj][m][0][1] * alpha; x0[2] = bf_lo(o.y) + acc[ai][bj][m][0][2] * alpha; x0[3] = bf_hi(o.y) + acc[ai][bj][m][0][3] * alpha;
                    x1[0] = bf_lo(o.z) + acc[ai][bj][m][1][0] * alpha; x1[1] = bf_hi(o.z) + acc[ai][bj][m][1][1] * alpha; x1[2] = bf_lo(o.w) + acc[ai][bj][m][1][2] * alpha; x1[3] = bf_hi(o.w) + acc[ai][bj][m][1][3] * alpha;
                    *(GAS u32x4*)((GAS bf16_t*)xb + off) = pack8f(x0, x1);
                    if (do_st) q += ((x0[0] * x0[0] + x0[1] * x0[1]) + (x0[2] * x0[2] + x0[3] * x0[3])) + ((x1[0] * x1[0] + x1[1] * x1[1]) + (x1[2] * x1[2] + x1[3] * x1[3])); }
                if (do_st) { q += __shfl_xor(q, 16); q += __shfl_xor(q, 32);
                    if (fq == 0) __hip_atomic_fetch_add((GAS u64*)st + row, (u64)(q * STAT_FIX), __ATOMIC_RELAXED, __HIP_MEMORY_SCOPE_AGENT); } }
            __builtin_amdgcn_sched_barrier(0);
        }
    }
};
template <int ACT> struct EpiBf16 {
    static constexpr bool PERM = true;
    bf16_t* O; int ldc; int ncols; const float* bias; const u64* st;
    __device__ __forceinline__ void operator()(const f32x4 (&acc)[2][2][4][2], const Unit& u, int wr, int wc, int fr, int fq) const {
        float rsv[2][4];
        if (st) { EPI_LOAD_RSTD(rs2, st)
#pragma unroll
            for (int ai = 0; ai < 2; ++ai)
#pragma unroll
                for (int m = 0; m < 4; ++m) rsv[ai][m] = rs2[ai][m]; }
#pragma unroll
        for (int bj = 0; bj < 2; ++bj) { const int c0 = u.pn * 256 + bj * 128 + wc * 32 + 8 * fq;
            if (c0 < ncols) {
                f32x4 bv0 = {0.f, 0.f, 0.f, 0.f}, bv1 = {0.f, 0.f, 0.f, 0.f};
                if (ACT == 2) { bv0 = *(const f32x4*)(bias + c0); bv1 = *(const f32x4*)(bias + c0 + 4); }
                EPI_ROWS_BEGIN
                    f32x4 v0 = acc[ai][bj][m][0], v1 = acc[ai][bj][m][1];
                    if (ACT == 2) { v0 = v0 + bv0; v1 = v1 + bv1; }
                    if (ACT == 1) {
                        const float kneg = st ? -rsv[ai][m] * LOG2E : -LOG2E;
#pragma unroll
                        for (int e = 0; e < 4; ++e) { v0[e] = __builtin_amdgcn_rcpf(1.0f + __builtin_amdgcn_exp2f(v0[e] * kneg)); v1[e] = __builtin_amdgcn_rcpf(1.0f + __builtin_amdgcn_exp2f(v1[e] * kneg)); } }
                    else if (st) { const float rs = rsv[ai][m]; v0 = v0 * rs; v1 = v1 * rs; }
                    if (ACT == 2) {
#pragma unroll
                        for (int e = 0; e < 4; ++e) { v0[e] = v0[e] * fast_sigmoid(v0[e]); v1[e] = v1[e] * fast_sigmoid(v1[e]); } }
                    __builtin_nontemporal_store(pack8f(v0, v1), (GAS u32x4*)((GAS bf16_t*)O + (size_t)row * ldc + c0));
                EPI_ROWS_END
            } }
    }
};
struct EpiBranch {
    static constexpr bool PERM = true;
    bf16_t* mixed; const bf16_t* G; int goff; int first;
    __device__ __forceinline__ void operator()(const f32x4 (&acc)[2][2][4][2], const Unit& u, int wr, int wc, int fr, int fq) const {
#pragma unroll
        for (int ai = 0; ai < 2; ++ai) {
            u32x4 gq[4][2], oq[4][2];
#pragma unroll
            for (int m = 0; m < 4; ++m)
#pragma unroll
                for (int bj = 0; bj < 2; ++bj) { const int row = u.pm * 256 + ai * 128 + wr * 64 + m * 16 + fr, c0 = u.pn * 256 + bj * 128 + wc * 32 + 8 * fq;
                    gq[m][bj] = *(const GAS u32x4*)((const GAS bf16_t*)G + (size_t)row * 6144 + goff + c0);
                    if (!first) oq[m][bj] = *(const GAS u32x4*)((const GAS bf16_t*)mixed + (size_t)row * 2048 + c0); }
#pragma unroll
            for (int m = 0; m < 4; ++m)
#pragma unroll
                for (int bj = 0; bj < 2; ++bj) { const int row = u.pm * 256 + ai * 128 + wr * 64 + m * 16 + fr, c0 = u.pn * 256 + bj * 128 + wc * 32 + 8 * fq;
                    const u32x4 g4 = gq[m][bj]; f32x4 v0, v1;
                    v0[0] = bf_lo(g4.x) * acc[ai][bj][m][0][0]; v0[1] = bf_hi(g4.x) * acc[ai][bj][m][0][1]; v0[2] = bf_lo(g4.y) * acc[ai][bj][m][0][2]; v0[3] = bf_hi(g4.y) * acc[ai][bj][m][0][3];
                    v1[0] = bf_lo(g4.z) * acc[ai][bj][m][1][0]; v1[1] = bf_hi(g4.z) * acc[ai][bj][m][1][1]; v1[2] = bf_lo(g4.w) * acc[ai][bj][m][1][2]; v1[3] = bf_hi(g4.w) * acc[ai][bj][m][1][3];
                    if (!first) { const u32x4 o = oq[m][bj];
                        v0[0] += bf_lo(o.x); v0[1] += bf_hi(o.x); v0[2] += bf_lo(o.y); v0[3] += bf_hi(o.y); v1[0] += bf_lo(o.z); v1[1] += bf_hi(o.z); v1[2] += bf_lo(o.w); v1[3] += bf_hi(o.w); }
                    *(GAS u32x4*)((GAS bf16_t*)mixed + (size_t)row * 2048 + c0) = pack8f(v0, v1); }
            asm volatile("" ::: "memory");
        }
    }
};
__device__ __forceinline__ void rope8(f32x4& v0, f32x4& v1, const f32x4 cs0, const f32x4 cs1) {
    const float a0 = v0[0] * cs0[0] - v0[1] * cs0[1], b0 = v0[0] * cs0[1] + v0[1] * cs0[0];
    const float a1 = v0[2] * cs0[2] - v0[3] * cs0[3], b1 = v0[2] * cs0[3] + v0[3] * cs0[2];
    const float a2 = v1[0] * cs1[0] - v1[1] * cs1[1], b2 = v1[0] * cs1[1] + v1[1] * cs1[0];
    const float a3 = v1[2] * cs1[2] - v1[3] * cs1[3], b3 = v1[2] * cs1[3] + v1[3] * cs1[2];
    v0 = (f32x4){a0, b0, a1, b1}; v1 = (f32x4){a2, b2, a3, b3};
}
struct EpiProj {
    static constexpr bool PERM = true;
    unsigned char* ws; const float* tab; const u64* st;
    __device__ __forceinline__ void operator()(const f32x4 (&acc)[2][2][4][2], const Unit& u, int wr, int wc, int fr, int fq) const {
        EPI_LOAD_RSTD(rsv, st)
#pragma unroll
        for (int bj = 0; bj < 2; ++bj) { const int c0 = u.pn * 256 + bj * 128 + wc * 32 + 8 * fq;
            int kind = 1, ld = 0, tabo = 0; float scale = 1.f; bf16_t* dst = nullptr;
            if (c0 < 768) { dst = (bf16_t*)(ws + B_CQ) + c0; ld = 768; }
            else if (c0 < 1280) { dst = (bf16_t*)(ws + B_CKV) + (c0 - 768); ld = 512; }
            else if (c0 < 1344) { const int p = c0 - 1280; kind = 4; tabo = p >> 1; dst = (bf16_t*)(ws + B_KM) + 128 + p; ld = 1152; }
            else if (c0 < 2112) { const int p = c0 - 1344, w = p % 192; kind = 2; tabo = 32 + (w >> 1); scale = QS192; dst = (bf16_t*)(ws + B_NQ) + p; ld = 768; }
            else if (c0 < 2304) { const int p = c0 - 2112; kind = 2; tabo = 32 + (p >> 1); dst = (bf16_t*)(ws + B_KCMP) + p; ld = 192; }
            else if (c0 < 2432) { dst = (bf16_t*)(ws + B_VCMP) + (c0 - 2304); ld = 128; }
            else if (c0 < 2624) { const int p = c0 - 2432; kind = 2; tabo = 32 + (p >> 1); dst = (bf16_t*)(ws + B_KSLC) + p; ld = 192; }
            else if (c0 < 2752) { dst = (bf16_t*)(ws + B_VSLC) + (c0 - 2624); ld = 128; }
            else if (c0 < 2944) { const int p = c0 - 2752; kind = 2; tabo = 32 + (p >> 1); dst = (bf16_t*)(ws + B_KWIN) + p; ld = 192; }
            else if (c0 < 3072) { dst = (bf16_t*)(ws + B_VWIN) + (c0 - 2944); ld = 128; }
            else if (c0 < 3088) { kind = 3; }
            else if (c0 < 3856) { const int p = c0 - 3088, w = p % 96; kind = 2; tabo = 128 + (w >> 1); scale = QS96; dst = (bf16_t*)(ws + B_DQ) + p; ld = 768; }
            else if (c0 < 4624) { const int p = c0 - 3856, w = p % 96; kind = 2; tabo = 128 + (w >> 1); dst = (bf16_t*)(ws + B_DK) + p; ld = 768; }
            else if (c0 < 5392) { dst = (bf16_t*)(ws + B_DV) + (c0 - 4624); ld = 768; }
            else kind = 0;
            if (kind == 0) continue;
#pragma unroll
            for (int ai = 0; ai < 2; ++ai) {
                f32x4 cs0[4], cs1[4];
                if (kind == 2 || kind == 4) {
#pragma unroll
                    for (int m = 0; m < 4; ++m) { const int row = u.pm * 256 + ai * 128 + wr * 64 + m * 16 + fr; const GAS float* tp = (const GAS float*)tab + ((size_t)(row & (SEQ - 1)) * NTAB + tabo) * 2;
                        cs0[m] = *(const GAS f32x4*)tp; cs1[m] = *(const GAS f32x4*)(tp + 4); }
                }
#pragma unroll
                for (int m = 0; m < 4; ++m) { const int row = u.pm * 256 + ai * 128 + wr * 64 + m * 16 + fr;
                const float rs = rsv[ai][m];
                f32x4 v0 = acc[ai][bj][m][0] * rs, v1 = acc[ai][bj][m][1] * rs;
                if (kind == 3) {
                    float* gp = (float*)(ws + B_NGATE) + (size_t)row * 16 + (c0 - 3072);
#pragma unroll
                    for (int e = 0; e < 4; ++e) { v0[e] = fast_sigmoid(v0[e]); v1[e] = fast_sigmoid(v1[e]); }
                    *(f32x4*)gp = v0; *(f32x4*)(gp + 4) = v1;
                } else {
                    if (kind == 2 || kind == 4) rope8(v0, v1, cs0[m], cs1[m]);
                    v0 = v0 * scale; v1 = v1 * scale;
                    const u32x4 w = pack8f(v0, v1);
                    bf16_t* p = dst + (size_t)row * ld;
                    *(u32x4*)p = w;
                    if (kind == 4) {
#pragma unroll
                        for (int hh = 1; hh < 6; ++hh) *(u32x4*)(p + hh * 192) = w; }
                }
                }
            }
        }
    }
};
struct EpiUq {
    static constexpr bool PERM = true;
    bf16_t* QM; const float* tab;
    __device__ __forceinline__ void operator()(const f32x4 (&acc)[2][2][4][2], const Unit& u, int wr, int wc, int fr, int fq) const {
#pragma unroll
        for (int bj = 0; bj < 2; ++bj) { const int c0 = u.pn * 256 + bj * 128 + wc * 32 + 8 * fq;
            if (c0 >= 1152) continue;
            const int w = c0 % 192; const bool rp = w >= 128; const int tabo = rp ? ((w - 128) >> 1) : 0;
#pragma unroll
            for (int ai = 0; ai < 2; ++ai) {
                f32x4 cs0[4], cs1[4];
                if (rp) {
#pragma unroll
                    for (int m = 0; m < 4; ++m) { const int row = u.pm * 256 + ai * 128 + wr * 64 + m * 16 + fr; const GAS float* tp = (const GAS float*)tab + ((size_t)(row & (SEQ - 1)) * NTAB + tabo) * 2;
                        cs0[m] = *(const GAS f32x4*)tp; cs1[m] = *(const GAS f32x4*)(tp + 4); }
                }
#pragma unroll
                for (int m = 0; m < 4; ++m) { const int row = u.pm * 256 + ai * 128 + wr * 64 + m * 16 + fr;
                    f32x4 v0 = acc[ai][bj][m][0], v1 = acc[ai][bj][m][1];
                    if (rp) rope8(v0, v1, cs0[m], cs1[m]);
                    v0 = v0 * QS192; v1 = v1 * QS192;
                    *(u32x4*)(QM + (size_t)row * 1152 + c0) = pack8f(v0, v1); }
            }
        }
    }
};
struct EpiUkv {
    static constexpr bool PERM = true;
    bf16_t* KM; bf16_t* VM;
    __device__ __forceinline__ void operator()(const f32x4 (&acc)[2][2][4][2], const Unit& u, int wr, int wc, int fr, int fq) const {
#pragma unroll
        for (int bj = 0; bj < 2; ++bj) { const int c0 = u.pn * 256 + bj * 128 + wc * 32 + 8 * fq;
            const int hh = c0 >> 8, w = c0 & 255;
            bf16_t* dst = (w < 128) ? (KM + hh * 192 + w) : (VM + hh * 128 + (w - 128)); const int ld = (w < 128) ? 1152 : 768;
            EPI_ROWS_BEGIN *(u32x4*)(dst + (size_t)row * ld) = pack8f(acc[ai][bj][m][0], acc[ai][bj][m][1]); EPI_ROWS_END
        }
    }
};

enum { MAP_ID = 0, MAP_PADN, MAP_FFN_IN, MAP_GATE, MAP_UQ, MAP_ROPE192, MAP_PROJ };
__device__ __forceinline__ int map_src(int kind, int n, int nvalid) {
    if (kind == MAP_ID) return n;
    if (kind == MAP_PADN) return n < nvalid ? n : -1;
    if (kind == MAP_FFN_IN) { const int pn = n >> 8, tc = n & 255; return (tc < 128) ? (pn * 128 + tc) : (DFF + pn * 128 + (tc - 128)); }
    if (kind == MAP_GATE) return 5388 + n;
    if (kind == MAP_ROPE192) return n < 192 ? (n >> 1) + 96 * (n & 1) : -1;
    if (kind == MAP_UQ) { if (n >= 1152) return -1; const int hh = n / 192, w = n % 192; if (w < 128) return n; const int p = w - 128; return hh * 192 + 128 + (p >> 1) + 32 * (p & 1); }
    if (n < 1280) return n;
    if (n < 1344) { const int p = n - 1280; return 1280 + (p >> 1) + 32 * (p & 1); }
    if (n < 2112) { const int p = n - 1344, hh = p / 192, w = p % 192; return 1344 + hh * 192 + (w >> 1) + 96 * (w & 1); }
    if (n < 2304) { const int p = n - 2112; return 2112 + (p >> 1) + 96 * (p & 1); }
    if (n < 2432) return n;
    if (n < 2624) { const int p = n - 2432; return 2432 + (p >> 1) + 96 * (p & 1); }
    if (n < 2752) return n;
    if (n < 2944) { const int p = n - 2752; return 2752 + (p >> 1) + 96 * (p & 1); }
    if (n < 3072) return n;
    if (n < 3088) { const int p = n - 3072; return p < 12 ? 3072 + p : -1; }
    if (n < 3856) { const int p = n - 3088, hs = p / 96, w = p % 96; return 3084 + hs * 96 + (w >> 1) + 48 * (w & 1); }
    if (n < 4624) { const int p = n - 3856, hs = p / 96, w = p % 96; return 3852 + hs * 96 + (w >> 1) + 48 * (w & 1); }
    if (n < 5392) return 4620 + (n - 4624);
    return -1;
}
__device__ __forceinline__ void conv_job(const float* W, int K, int ldw, int kind, int nvalid, bf16_t* WT, int ndst, LAS float* scr, int gw, int ngw, int lane, bool krope192 = false, const float* kscale = nullptr) {
    const int nblk = ndst / 32, nitems = (K / 64) * nblk;
    for (int item = gw; item < nitems; item += ngw) {
        const int kb = item / nblk, nb = item % nblk, k0 = 64 * kb, n0 = 32 * nb;
        const int sc = map_src(kind, n0 + (lane & 31), nvalid);
        const GAS float* src = (const GAS float*)W + (sc < 0 ? 0 : sc);
        float vals[32];
#pragma unroll
        for (int i = 0; i < 32; ++i) { int kr = k0 + 2 * i + (lane >> 5);
            if (krope192) { const int l_ = kr / 192, dp = kr % 192; kr = l_ * 192 + (dp >> 1) + 96 * (dp & 1); }
            vals[i] = src[(size_t)kr * ldw]; }
        const float gsc = kscale ? ((const GAS float*)kscale)[k0 + lane] : 1.0f;
#pragma unroll
        for (int i = 0; i < 32; ++i) scr[(2 * i + (lane >> 5)) * 33 + (lane & 31)] = (sc >= 0) ? vals[i] : 0.f;
        scr[64 * 33 + lane] = gsc;
        asm volatile("s_waitcnt lgkmcnt(0)" ::: "memory");
        const int c = lane & 7;
        float gk[8];
#pragma unroll
        for (int kk = 0; kk < 8; ++kk) gk[kk] = scr[64 * 33 + 8 * c + kk];
#pragma unroll
        for (int j = 0; j < 4; ++j) { const int n = (lane >> 3) + 8 * j; const LAS float* s = scr + (8 * c) * 33 + n;
            u32x4 o; o.x = cvt_pk_bf16(s[0 * 33] * gk[0], s[1 * 33] * gk[1]); o.y = cvt_pk_bf16(s[2 * 33] * gk[2], s[3 * 33] * gk[3]); o.z = cvt_pk_bf16(s[4 * 33] * gk[4], s[5 * 33] * gk[5]); o.w = cvt_pk_bf16(s[6 * 33] * gk[6], s[7 * 33] * gk[7]);
            *(GAS u32x4*)((GAS bf16_t*)WT + (size_t)(n0 + n) * K + k0 + 8 * c) = o; }
        asm volatile("s_waitcnt lgkmcnt(0)" ::: "memory");
    }
}
__device__ __forceinline__ void rms_row_bf16(const float* xrow, const float* w, bf16_t* orow, int lane) {
    const GAS f32x4* xr = (const GAS f32x4*)xrow + lane; const GAS f32x4* wr_ = (const GAS f32x4*)w + lane;
    f32x4 v[8]; float s = 0.f;
#pragma unroll
    for (int j = 0; j < 8; ++j) { v[j] = xr[64 * j]; s += (v[j][0] * v[j][0] + v[j][1] * v[j][1]) + (v[j][2] * v[j][2] + v[j][3] * v[j][3]); }
    const float rstd = 1.0f / sqrtf(wave_sum(s) * (1.0f / D) + EPS);
    GAS u32x2* o8 = (GAS u32x2*)orow + lane;
#pragma unroll
    for (int j = 0; j < 8; ++j) { const f32x4 g = wr_[64 * j]; u32x2 o; o.x = cvt_pk_bf16(v[j][0] * rstd * g[0], v[j][1] * rstd * g[1]); o.y = cvt_pk_bf16(v[j][2] * rstd * g[2], v[j][3] * rstd * g[3]); o8[64 * j] = o; }
}
__device__ __forceinline__ void xb_row_stats(const float* xrow, bf16_t* orow, u64* st, int lane) {
    const GAS f32x4* xr = (const GAS f32x4*)xrow + lane;
    f32x4 v[8]; float s = 0.f;
#pragma unroll
    for (int j = 0; j < 8; ++j) { v[j] = xr[64 * j]; s += (v[j][0] * v[j][0] + v[j][1] * v[j][1]) + (v[j][2] * v[j][2] + v[j][3] * v[j][3]); }
    s = wave_sum(s);
    GAS u32x2* o8 = (GAS u32x2*)orow + lane;
#pragma unroll
    for (int j = 0; j < 8; ++j) { u32x2 o; o.x = cvt_pk_bf16(v[j][0], v[j][1]); o.y = cvt_pk_bf16(v[j][2], v[j][3]); o8[64 * j] = o; }
    if (lane == 0) *st = (u64)(s * STAT_FIX);
}
__device__ __forceinline__ void rms_row_out(const bf16_t* xrow, float* orow, const float* w, int lane) {
    const GAS u32x4* xr = (const GAS u32x4*)xrow + lane;
    u32x4 v[4]; float s = 0.f;
#pragma unroll
    for (int j = 0; j < 4; ++j) { v[j] = xr[64 * j];
        s += ((bf_lo(v[j].x) * bf_lo(v[j].x) + bf_hi(v[j].x) * bf_hi(v[j].x)) + (bf_lo(v[j].y) * bf_lo(v[j].y) + bf_hi(v[j].y) * bf_hi(v[j].y)))
           + ((bf_lo(v[j].z) * bf_lo(v[j].z) + bf_hi(v[j].z) * bf_hi(v[j].z)) + (bf_lo(v[j].w) * bf_lo(v[j].w) + bf_hi(v[j].w) * bf_hi(v[j].w))); }
    const float rstd = 1.0f / sqrtf(wave_sum(s) * (1.0f / D) + EPS);
#pragma unroll
    for (int j = 0; j < 4; ++j) { const int c = 8 * (lane + 64 * j); const f32x4 g0 = *(const f32x4*)(w + c), g1 = *(const f32x4*)(w + c + 4);
        const f32x4 y0 = {bf_lo(v[j].x) * rstd * g0[0], bf_hi(v[j].x) * rstd * g0[1], bf_lo(v[j].y) * rstd * g0[2], bf_hi(v[j].y) * rstd * g0[3]};
        const f32x4 y1 = {bf_lo(v[j].z) * rstd * g1[0], bf_hi(v[j].z) * rstd * g1[1], bf_lo(v[j].w) * rstd * g1[2], bf_hi(v[j].w) * rstd * g1[3]};
        *(GAS f32x4*)((GAS float*)orow + c) = y0; *(GAS f32x4*)((GAS float*)orow + c + 4) = y1; }
}
template <int NC> __device__ __forceinline__ void rms_row_inplace_bf16(bf16_t* row, const float* w, int lane) {
    u32x2* p = (u32x2*)row + lane; float v[NC / 256][4]; float s = 0.f;
#pragma unroll
    for (int j = 0; j < NC / 256; ++j) { const u32x2 q = p[64 * j]; v[j][0] = bf_lo(q.x); v[j][1] = bf_hi(q.x); v[j][2] = bf_lo(q.y); v[j][3] = bf_hi(q.y);
        s += (v[j][0] * v[j][0] + v[j][1] * v[j][1]) + (v[j][2] * v[j][2] + v[j][3] * v[j][3]); }
    const float rstd = 1.0f / sqrtf(wave_sum(s) * (1.0f / NC) + EPS);
#pragma unroll
    for (int j = 0; j < NC / 256; ++j) { const f32x4 g = *((const f32x4*)w + lane + 64 * j); u32x2 o; o.x = cvt_pk_bf16(v[j][0] * rstd * g[0], v[j][1] * rstd * g[1]); o.y = cvt_pk_bf16(v[j][2] * rstd * g[2], v[j][3] * rstd * g[3]); p[64 * j] = o; }
}
__device__ __forceinline__ void rope_entry(int pos, int fi, float& c, float& s) {
    double r; int i;
    if (fi < 32) { r = 0.7498942093324558273; i = fi; } else if (fi < 128) { r = 0.9085175756516867878; i = fi - 32; } else { r = 0.8254041852680184257; i = fi - 128; }
    double inv = 1.0, b = r; int e = i;
#pragma unroll
    for (int k = 0; k < 7; ++k) { if (e & 1) inv *= b; b *= b; e >>= 1; }
    const float ang = (float)pos * (float)inv;
    const double x = (double)ang;
    const double n = __builtin_rint(x * 0.6366197723675814);
    double y = __builtin_fma(-n, 1.5707963267948966, x); y = __builtin_fma(-n, 6.123233995736766e-17, y);
    const double y2 = y * y;
    double sp = 1.0 / 362880.0; sp = sp * y2 - 1.0 / 5040.0; sp = sp * y2 + 1.0 / 120.0; sp = sp * y2 - 1.0 / 6.0; sp = sp * y2 + 1.0; sp *= y;
    double cp = -1.0 / 3628800.0; cp = cp * y2 + 1.0 / 40320.0; cp = cp * y2 - 1.0 / 720.0; cp = cp * y2 + 1.0 / 24.0; cp = cp * y2 - 0.5; cp = cp * y2 + 1.0;
    const int q = ((int)n) & 3;
    const double sn = (q == 0) ? sp : (q == 1) ? cp : (q == 2) ? -sp : -cp;
    const double cn = (q == 0) ? cp : (q == 1) ? -sp : (q == 2) ? -cp : sp;
    c = (float)cn; s = (float)sn;
}

template <int DK, int DV> struct AT {
    static constexpr int KROW = DK * 2 + 16, VROW = DV * 2 + 64, KBUF = 64 * KROW, VBUF = 64 * VROW;
    static constexpr int KCPR = DK / 8, VCPR = DV / 8, KCH = 64 * KCPR, VCH = 64 * VCPR, KN = (KCH + 511) / 512, VN = (VCH + 511) / 512;
    static constexpr int NS = DK / 16, NDB = DV / 32;
};
struct AttnSrc { const bf16_t* K; const bf16_t* V; int ks, vs; };
constexpr float ATT_THR = 6.0f;
constexpr float NEG_INF_F = -__builtin_inff();

__device__ __forceinline__ bf16x8 pack_p(const f32x16& p, int b) {
    u32x4 w; w.x = cvt_pk_bf16(p[b + 0], p[b + 1]); w.y = cvt_pk_bf16(p[b + 2], p[b + 3]); w.z = cvt_pk_bf16(p[b + 4], p[b + 5]); w.w = cvt_pk_bf16(p[b + 6], p[b + 7]);
    return *reinterpret_cast<bf16x8*>(&w);
}
template <int DK, int DV, int MODE>
__device__ __forceinline__ void attn_core(LAS unsigned char* lds, const AttnSrc src, const int j_lo, const int j_hi, const bf16x8 (&qf)[DK / 16],
                                          const int qhi, const unsigned W, const int qmin_w, const int qmax_w, float& m_run, float& l_run, f32x16 (&O)[DV / 32],
                                          const LAS unsigned* selrow, const LAS unsigned* selwave, const float inv_l, LAS float* strip, LAS float* impsel_w) {
    using A = AT<DK, DV>;
    const int tid = opaque_tid(), lane = tid & 63, r = lane & 31, h = lane >> 5;
    const int nt = j_hi - j_lo;
    if (nt <= 0) return;
    LAS unsigned char* Kb = lds; LAS unsigned char* Vb = lds + 2 * A::KBUF;
    unsigned koff[A::KN], klds[A::KN], voff[A::VN], vlds[A::VN];
#pragma unroll
    for (int i = 0; i < A::KN; ++i) { const int id = tid + 512 * i, row = id / A::KCPR, c = id % A::KCPR; koff[i] = (unsigned)(row * src.ks + c * 8); klds[i] = (unsigned)(row * A::KROW + c * 16); }
#pragma unroll
    for (int i = 0; i < A::VN; ++i) { const int id = tid + 512 * i, row = id / A::VCPR, c = id % A::VCPR; voff[i] = (unsigned)(row * src.vs + c * 8); vlds[i] = (unsigned)(row * A::VROW + c * 16); }
    const bool klast = (tid + 512 * (A::KN - 1)) < A::KCH, vlast = (tid + 512 * (A::VN - 1)) < A::VCH;
    bf16x8 sk[A::KN], sv[A::VN];
    constexpr bool KFULL = (A::KCH % 512) == 0, VFULL = (A::VCH % 512) == 0;
#define AT_ISSUE(t_) do { const GAS bf16_t* kp_ = (const GAS bf16_t*)src.K + (size_t)(t_) * 64 * src.ks; \
        _Pragma("unroll") for (int i = 0; i < A::KN; ++i) if (i < A::KN - 1 || KFULL || klast) sk[i] = *(const GAS bf16x8*)(kp_ + koff[i]); \
        if (MODE != 2) { const GAS bf16_t* vp_ = (const GAS bf16_t*)src.V + (size_t)(t_) * 64 * src.vs; \
        _Pragma("unroll") for (int i = 0; i < A::VN; ++i) if (i < A::VN - 1 || VFULL || vlast) sv[i] = *(const GAS bf16x8*)(vp_ + voff[i]); } } while (0)
#define AT_WRITE(b_) do { \
        _Pragma("unroll") for (int i = 0; i < A::KN; ++i) if (i < A::KN - 1 || KFULL || klast) *(LAS bf16x8*)(Kb + (b_) * A::KBUF + klds[i]) = sk[i]; \
        if (MODE != 2) { _Pragma("unroll") for (int i = 0; i < A::VN; ++i) if (i < A::VN - 1 || VFULL || vlast) *(LAS bf16x8*)(Vb + (b_) * A::VBUF + vlds[i]) = sv[i]; } } while (0)
    __syncthreads();
    AT_ISSUE(j_lo); AT_WRITE(0);
    __syncthreads();
    const int g4 = lane >> 4, q4 = (lane >> 2) & 3, p4 = lane & 3;
    const int vlane = (4 * (g4 >> 1) + q4) * A::VROW + (16 * (g4 & 1) + 4 * p4) * 2;
    for (int it = 0; it < nt; ++it) {
        const int t = j_lo + it, cur = it & 1; bool wrote = false;
        if (it + 1 < nt) AT_ISSUE(t + 1);
        const int kbase = 64 * t;
        bool active_v = (kbase <= qmax_w) && ((long long)kbase + 63 > (long long)qmin_w - (long long)W);
        if (MODE == 1) { const unsigned uw = selwave[t >> 5]; active_v = active_v && ((uw >> (t & 31)) & 1u); }
        const bool active = __builtin_amdgcn_readfirstlane((int)active_v) != 0;
        if (active) {
            f32x16 p0, p1;
            const float base = (MODE != 2 && m_run > -1e29f) ? m_run : 0.f;
#pragma unroll
            for (int i = 0; i < 16; ++i) { p0[i] = -base; p1[i] = -base; }
            const LAS unsigned char* kb = Kb + cur * A::KBUF + r * A::KROW + h * 16;
            {
                bf16x8 fa[A::NS], fb[A::NS];
#pragma unroll
                for (int s = 0; s < 2; ++s) { fa[s] = *(const LAS bf16x8*)(kb + s * 32); fb[s] = *(const LAS bf16x8*)(kb + 32 * A::KROW + s * 32); }
#pragma unroll
                for (int s = 0; s < A::NS; ++s) {
                    if (s + 2 < A::NS) { fa[s + 2] = *(const LAS bf16x8*)(kb + (s + 2) * 32); fb[s + 2] = *(const LAS bf16x8*)(kb + 32 * A::KROW + (s + 2) * 32); }
                    p0 = __builtin_amdgcn_mfma_f32_32x32x16_bf16(fa[s], qf[s], p0, 0, 0, 0);
                    p1 = __builtin_amdgcn_mfma_f32_32x32x16_bf16(fb[s], qf[s], p1, 0, 0, 0);
                }
                __builtin_amdgcn_sched_group_barrier(0x100, 4, 0);
#pragma unroll
                for (int s = 0; s < A::NS; ++s) { __builtin_amdgcn_sched_group_barrier(0x008, 2, 0); if (s + 2 < A::NS) __builtin_amdgcn_sched_group_barrier(0x100, 2, 0); }
            }
            bool row_on = true;
            if (MODE == 1) { const unsigned rw = selrow[t >> 5]; row_on = (rw >> (t & 31)) & 1u; }
            bool need_mask = !((qmin_w >= kbase + 63) && ((long long)qmax_w - (long long)W < (long long)kbase));
            if (MODE == 1) need_mask = need_mask || !__all(row_on);
            if (need_mask) {
                const int dq = qhi - kbase - 4 * h;
#pragma unroll
                for (int i = 0; i < 16; ++i) { const int c = (i & 3) + 8 * (i >> 2);
                    if (!(row_on && (unsigned)(dq - c) < W)) p0[i] = NEG_INF_F;
                    if (!(row_on && (unsigned)(dq - c - 32) < W)) p1[i] = NEG_INF_F; }
            }
            if (MODE != 2) {
                float tmax = p0[0];
#pragma unroll
                for (int i = 1; i < 16; ++i) tmax = fmaxf(tmax, p0[i]);
#pragma unroll
                for (int i = 0; i < 16; ++i) tmax = fmaxf(tmax, p1[i]);
                { const auto rr_ = __builtin_amdgcn_permlane32_swap(__float_as_uint(tmax), __float_as_uint(tmax), false, false); tmax = fmaxf(__uint_as_float(rr_[0]), __uint_as_float(rr_[1])); }
                if (!__all(tmax + (base - m_run) <= ATT_THR)) {
                    const float mn = fmaxf(m_run, tmax + base); const float alpha = __builtin_amdgcn_exp2f(m_run - mn); const float dsh = mn - base; m_run = mn; l_run *= alpha;
#pragma unroll
                    for (int i = 0; i < 16; ++i) { p0[i] -= dsh; p1[i] -= dsh; }
#pragma unroll
                    for (int db = 0; db < A::NDB; ++db)
#pragma unroll
                        for (int i = 0; i < 16; ++i) O[db][i] *= alpha;
                }
#pragma unroll
                for (int i = 0; i < 16; ++i) { p0[i] = __builtin_amdgcn_exp2f(p0[i]); p1[i] = __builtin_amdgcn_exp2f(p1[i]); }
                bf16x8 pb[2][2];
                pb[0][0] = pack_p(p0, 0); pb[0][1] = pack_p(p0, 8); pb[1][0] = pack_p(p1, 0); pb[1][1] = pack_p(p1, 8);
                {   float rs = 0.f;
#pragma unroll
                    for (int i = 0; i < 16; ++i) rs += p0[i] + p1[i];
                    { const auto rr_ = __builtin_amdgcn_permlane32_swap(__float_as_uint(rs), __float_as_uint(rs), false, false); rs = __uint_as_float(rr_[0]) + __uint_as_float(rr_[1]); } l_run += rs; }
                const LAS unsigned char* vb = Vb + cur * A::VBUF + vlane;
                {
                    constexpr int NSTEP = A::NDB * 4;
                    s16x4 vlo[NSTEP], vhi[NSTEP];
#define AT_VOFF(k_) ((32 * (((k_) >> 1) & 1) + 16 * ((k_) & 1)) * A::VROW + 64 * ((k_) >> 2))
#pragma unroll
                    for (int k = 0; k < 2; ++k) { vlo[k] = __builtin_amdgcn_ds_read_tr16_b64_v4i16((LAS s16x4*)(vb + AT_VOFF(k))); vhi[k] = __builtin_amdgcn_ds_read_tr16_b64_v4i16((LAS s16x4*)(vb + AT_VOFF(k) + 8 * A::VROW)); }
#pragma unroll
                    for (int k = 0; k < NSTEP; ++k) {
                        if (k + 2 < NSTEP) { vlo[k + 2] = __builtin_amdgcn_ds_read_tr16_b64_v4i16((LAS s16x4*)(vb + AT_VOFF(k + 2))); vhi[k + 2] = __builtin_amdgcn_ds_read_tr16_b64_v4i16((LAS s16x4*)(vb + AT_VOFF(k + 2) + 8 * A::VROW)); }
                        const bf16x8 av = {vlo[k][0], vlo[k][1], vlo[k][2], vlo[k][3], vhi[k][0], vhi[k][1], vhi[k][2], vhi[k][3]};
                        O[k >> 2] = __builtin_amdgcn_mfma_f32_32x32x16_bf16(av, pb[(k >> 1) & 1][k & 1], O[k >> 2], 0, 0, 0);
                    }
                    __builtin_amdgcn_sched_group_barrier(0x100, 4, 1);
#pragma unroll
                    for (int k = 0; k < NSTEP; ++k) { __builtin_amdgcn_sched_group_barrier(0x008, 1, 1); if (k + 2 < NSTEP) __builtin_amdgcn_sched_group_barrier(0x100, 2, 1); }
#undef AT_VOFF
                }
            } else {
#pragma unroll
                for (int i = 0; i < 16; ++i) {
                    float a = __builtin_amdgcn_exp2f(p0[i] - m_run) * inv_l, b = __builtin_amdgcn_exp2f(p1[i] - m_run) * inv_l;
                    a += __shfl_xor(a, 8); b += __shfl_xor(b, 8); a += __shfl_xor(a, 16); b += __shfl_xor(b, 16);
                    p0[i] = a; p1[i] = b;
                }
                if (r < 8) {
                    LAS float* sp = strip + r * 68 + 4 + 4 * h;
#pragma unroll
                    for (int i4 = 0; i4 < 4; ++i4) {
                        *(LAS f32x4*)(sp + 8 * i4) = (f32x4){p0[4 * i4], p0[4 * i4 + 1], p0[4 * i4 + 2], p0[4 * i4 + 3]};
                        *(LAS f32x4*)(sp + 32 + 8 * i4) = (f32x4){p1[4 * i4], p1[4 * i4 + 1], p1[4 * i4 + 2], p1[4 * i4 + 3]};
                    }
                }
                asm volatile("s_waitcnt lgkmcnt(0)" ::: "memory");
                {
                    const int q = lane >> 3, jp = lane & 7;
                    const LAS float* sp = strip + q * 68 + 8 * jp + 3;
                    float f[9];
#pragma unroll
                    for (int k = 0; k < 9; ++k) f[k] = sp[k];
                    const float s0 = f[0] + 2.f * (f[1] + f[2] + f[3]) + f[4], s1 = f[4] + 2.f * (f[5] + f[6] + f[7]) + f[8];
                    LAS float* ip = impsel_w + q * 256 + 16 * t + 2 * jp;
                    ip[0] = s0; ip[1] = s1;
                    asm volatile("s_waitcnt lgkmcnt(0)" ::: "memory");
                    if (jp == 7) strip[q * 68 + 3] = f[8];
                }
                asm volatile("s_waitcnt lgkmcnt(0)" ::: "memory");
            }
        } else if (MODE == 2) {
            const int q = lane >> 3, jp = lane & 7;
            LAS float* ip = impsel_w + q * 256 + 16 * t + 2 * jp; ip[0] = 0.f; ip[1] = 0.f;
            if (jp == 7) strip[q * 68 + 3] = 0.f;
        }
        if (it + 1 < nt && !wrote) AT_WRITE(cur ^ 1);
        __syncthreads();
    }
#undef AT_ISSUE
#undef AT_WRITE
}

template <int NDB> __device__ __forceinline__ void store_row(bf16_t* orow, const f32x16 (&O)[NDB], float scale, int h) {
#pragma unroll
    for (int db = 0; db < NDB; ++db)
#pragma unroll
        for (int i4 = 0; i4 < 4; ++i4) { u32x2 w; w.x = cvt_pk_bf16(O[db][4 * i4] * scale, O[db][4 * i4 + 1] * scale); w.y = cvt_pk_bf16(O[db][4 * i4 + 2] * scale, O[db][4 * i4 + 3] * scale);
            *(u32x2*)(orow + 32 * db + 8 * i4 + 4 * h) = w; }
}
template <int NDB> __device__ __forceinline__ void accum_row(bf16_t* orow, const f32x16 (&O)[NDB], float scale, int h) {
#pragma unroll
    for (int db = 0; db < NDB; ++db)
#pragma unroll
        for (int i4 = 0; i4 < 4; ++i4) { u32x2* p = (u32x2*)(orow + 32 * db + 8 * i4 + 4 * h); const u32x2 o = *p; u32x2 w;
            w.x = cvt_pk_bf16(bf_lo(o.x) + O[db][4 * i4] * scale, bf_hi(o.x) + O[db][4 * i4 + 1] * scale);
            w.y = cvt_pk_bf16(bf_lo(o.y) + O[db][4 * i4 + 2] * scale, bf_hi(o.y) + O[db][4 * i4 + 3] * scale); *p = w; }
}
template <int NDB> __device__ __forceinline__ void zero_o(f32x16 (&O)[NDB]) {
#pragma unroll
    for (int db = 0; db < NDB; ++db)
#pragma unroll
        for (int i = 0; i < 16; ++i) O[db][i] = 0.f;
}

__device__ __forceinline__ float xchg_max16(float x) { const auto r_ = __builtin_amdgcn_permlane16_swap(__float_as_uint(x), __float_as_uint(x), false, false); return fmaxf(__uint_as_float(r_[0]), __uint_as_float(r_[1])); }
__device__ __forceinline__ float xchg_max32(float x) { const auto r_ = __builtin_amdgcn_permlane32_swap(__float_as_uint(x), __float_as_uint(x), false, false); return fmaxf(__uint_as_float(r_[0]), __uint_as_float(r_[1])); }
__device__ __forceinline__ float xchg_add16(float x) { const auto r_ = __builtin_amdgcn_permlane16_swap(__float_as_uint(x), __float_as_uint(x), false, false); return __uint_as_float(r_[0]) + __uint_as_float(r_[1]); }
__device__ __forceinline__ float xchg_add32(float x) { const auto r_ = __builtin_amdgcn_permlane32_swap(__float_as_uint(x), __float_as_uint(x), false, false); return __uint_as_float(r_[0]) + __uint_as_float(r_[1]); }
template <int DK, int DV, int RB>
__device__ __forceinline__ void sel16_rb(const LAS unsigned char* kE, const LAS unsigned char* kO, const LAS unsigned char* vb, const bf16x8 (&qf)[2][DK / 32], const int qhi, const int kbase, const bool diag,
                                         const bool on, const int g, float (&m_run)[2], float (&l_run)[2], f32x4 (&O)[DV / 16][2]) {
    constexpr int KROWB = DK * 2, VROWB = DV * 2 + 32, NS = DK / 32, NDB = DV / 16;
    const float base = (m_run[RB] > -1e29f) ? m_run[RB] : 0.f;
    f32x4 S[4];
#pragma unroll
    for (int kb = 0; kb < 4; ++kb) S[kb] = (f32x4){-base, -base, -base, -base};
    {
        constexpr int KLA = 8;
        bf16x8 fr[NS * 4];
#define S16_KADDR(f_) (((((f_) >> 2) & 1) ? kO : kE) + ((f_) & 3) * 16 * KROWB + 128 * ((f_) >> 3))
#pragma unroll
        for (int f = 0; f < KLA; ++f) fr[f] = *(const LAS bf16x8*)S16_KADDR(f);
#pragma unroll
        for (int f = 0; f < NS * 4; ++f) {
            if (f + KLA < NS * 4) fr[f + KLA] = *(const LAS bf16x8*)S16_KADDR(f + KLA);
            S[f & 3] = __builtin_amdgcn_mfma_f32_16x16x32_bf16(fr[f], qf[RB][f >> 2], S[f & 3], 0, 0, 0);
        }
        __builtin_amdgcn_sched_group_barrier(0x100, KLA, 0);
#pragma unroll
        for (int f = 0; f < NS * 4; ++f) { __builtin_amdgcn_sched_group_barrier(0x008, 1, 0); if (f + KLA < NS * 4) __builtin_amdgcn_sched_group_barrier(0x100, 1, 0); }
#undef S16_KADDR
    }
    constexpr int NSTEP = NDB * 2, VLA = 4;
    s16x4 vlo[NSTEP], vhi[NSTEP];
#define S16_VOFF(k_) ((32 * ((k_) & 1)) * VROWB + 32 * ((k_) >> 1))
#pragma unroll
    for (int k = 0; k < VLA; ++k) { vlo[k] = __builtin_amdgcn_ds_read_tr16_b64_v4i16((LAS s16x4*)(vb + S16_VOFF(k))); vhi[k] = __builtin_amdgcn_ds_read_tr16_b64_v4i16((LAS s16x4*)(vb + S16_VOFF(k) + 16 * VROWB)); }
    __builtin_amdgcn_sched_barrier(0);
    if (diag || !__all(on)) { const int dq = qhi - kbase - 4 * g;
#pragma unroll
        for (int kb = 0; kb < 4; ++kb)
#pragma unroll
            for (int j = 0; j < 4; ++j) if (!(on && (dq - 16 * kb - j) >= 0)) S[kb][j] = NEG_INF_F; }
    float m_ = S[0][0];
#pragma unroll
    for (int kb = 0; kb < 4; ++kb)
#pragma unroll
        for (int j = 0; j < 4; ++j) m_ = fmaxf(m_, S[kb][j]);
    const float tmax = xchg_max32(xchg_max16(m_));
    if (!__all(tmax + (base - m_run[RB]) <= ATT_THR)) {
        const float mn = fmaxf(m_run[RB], tmax + base); const float alpha = __builtin_amdgcn_exp2f(m_run[RB] - mn); const float dsh = mn - base;
        m_run[RB] = mn; l_run[RB] *= alpha;
#pragma unroll
        for (int kb = 0; kb < 4; ++kb) S[kb] = S[kb] - dsh;
#pragma unroll
        for (int db = 0; db < NDB; ++db) O[db][RB] = O[db][RB] * alpha;
    }
    float rs = 0.f;
#pragma unroll
    for (int kb = 0; kb < 4; ++kb)
#pragma unroll
        for (int j = 0; j < 4; ++j) { S[kb][j] = __builtin_amdgcn_exp2f(S[kb][j]); rs += S[kb][j]; }
    l_run[RB] += xchg_add32(xchg_add16(rs));
    bf16x8 pb[2];
#pragma unroll
    for (int m = 0; m < 2; ++m) { const u32x4 w = pack8f(S[2 * m], S[2 * m + 1]); pb[m] = *reinterpret_cast<const bf16x8*>(&w); }
    {
#pragma unroll
        for (int k = 0; k < NSTEP; ++k) {
            if (k + VLA < NSTEP) { vlo[k + VLA] = __builtin_amdgcn_ds_read_tr16_b64_v4i16((LAS s16x4*)(vb + S16_VOFF(k + VLA))); vhi[k + VLA] = __builtin_amdgcn_ds_read_tr16_b64_v4i16((LAS s16x4*)(vb + S16_VOFF(k + VLA) + 16 * VROWB)); }
            const bf16x8 av = {vlo[k][0], vlo[k][1], vlo[k][2], vlo[k][3], vhi[k][0], vhi[k][1], vhi[k][2], vhi[k][3]};
            O[k >> 1][RB] = __builtin_amdgcn_mfma_f32_16x16x32_bf16(av, pb[k & 1], O[k >> 1][RB], 0, 0, 0);
        }
#pragma unroll
        for (int k = 0; k < NSTEP; ++k) { __builtin_amdgcn_sched_group_barrier(0x008, 1, 1); if (k + VLA < NSTEP) __builtin_amdgcn_sched_group_barrier(0x100, 2, 1); }
#undef S16_VOFF
    }
}
template <int DK, int DV>
__device__ __forceinline__ void attn_sel16(LAS unsigned char* lds, const AttnSrc src, const int j_hi, const bf16x8 (&qf)[2][DK / 32], const int (&qhi)[2], const int qmin_w,
                                           const LAS unsigned* sel0, const LAS unsigned* sel1, const LAS unsigned* selrb, float (&m_run)[2], float (&l_run)[2], f32x4 (&O)[DV / 16][2]) {
    constexpr int KROWB = DK * 2, VROWB = DV * 2 + 32, KBUF = 64 * KROWB, VBUF = 64 * VROWB;
    constexpr int KCPR = DK / 8, VCPR = DV / 8, KN = (64 * KCPR) / 512, VN = (64 * VCPR) / 512;
    static_assert((64 * KCPR) % 512 == 0 && (64 * VCPR) % 512 == 0 && KCPR % 8 == 0, "attn_sel16: tile shapes");
    const int tid = opaque_tid(), lane = tid & 63, c = lane & 15, g = lane >> 4;
    const int nt = j_hi;
    if (nt <= 0) return;
    LAS unsigned char* Kb = lds; LAS unsigned char* Vb = lds + 2 * KBUF;
    unsigned koff[KN], klds[KN], voff[VN], vlds[VN];
#pragma unroll
    for (int i = 0; i < KN; ++i) { const int id = tid + 512 * i, row = id / KCPR, ch = id % KCPR; koff[i] = (unsigned)(row * src.ks + ch * 8); klds[i] = (unsigned)(row * KROWB + ((ch ^ ((row >> 1) & 7)) * 16)); }
#pragma unroll
    for (int i = 0; i < VN; ++i) { const int id = tid + 512 * i, row = id / VCPR, ch = id % VCPR; voff[i] = (unsigned)(row * src.vs + ch * 8); vlds[i] = (unsigned)(row * VROWB + ch * 16); }
    bf16x8 sk[KN], sv[VN];
#define S16_ISSUE(t_) do { const GAS bf16_t* kp_ = (const GAS bf16_t*)src.K + (size_t)(t_) * 64 * src.ks; const GAS bf16_t* vp_ = (const GAS bf16_t*)src.V + (size_t)(t_) * 64 * src.vs; \
        _Pragma("unroll") for (int i = 0; i < KN; ++i) sk[i] = *(const GAS bf16x8*)(kp_ + koff[i]); \
        _Pragma("unroll") for (int i = 0; i < VN; ++i) sv[i] = *(const GAS bf16x8*)(vp_ + voff[i]); } while (0)
#define S16_WRITE(b_) do { \
        _Pragma("unroll") for (int i = 0; i < KN; ++i) *(LAS bf16x8*)(Kb + (b_) * KBUF + klds[i]) = sk[i]; \
        _Pragma("unroll") for (int i = 0; i < VN; ++i) *(LAS bf16x8*)(lds + 3 * KBUF + (b_) * VBUF + vlds[i]) = sv[i]; } while (0)
    __syncthreads();
    S16_ISSUE(0); S16_WRITE(0);
    __syncthreads();
    const int kswz = (c >> 1) & 7;
    const int kbE = c * KROWB + 16 * (g ^ kswz), kbO = c * KROWB + 16 * ((4 + g) ^ kswz);
    const int q4 = (lane >> 2) & 3, p4 = lane & 3;
    const int vlane = (4 * g + q4) * VROWB + 8 * p4;
    LAS unsigned char* Vr = lds + 3 * KBUF;
#define S16_RUN(RB_, t_, slot_) do { const int tt_ = (t_), kbase = 64 * tt_; const bool diag = (kbase + 63 > qmin_w); \
        const bool on_ = ((((RB_) == 0 ? sel0 : sel1)[tt_ >> 5] >> (tt_ & 31)) & 1u) != 0u; \
        const LAS unsigned char* kE = Kb + (slot_) * KBUF + kbE; const LAS unsigned char* kO = Kb + (slot_) * KBUF + kbO; const LAS unsigned char* vb = Vr + (slot_) * VBUF + vlane; \
        sel16_rb<DK, DV, RB_>(kE, kO, vb, qf, qhi[RB_], kbase, diag, on_, g, m_run, l_run, O); } while (0)
    int slot = 0, pslot = 2; bool deferred = false;
    for (int it = 0; it < nt; ++it) {
        const int t = it, nslot = (slot == 2) ? 0 : slot + 1;
        if (it + 1 < nt) S16_ISSUE(t + 1);
        const unsigned ub0 = (unsigned)__builtin_amdgcn_readfirstlane((int)selrb[t >> 5]), ub1 = (unsigned)__builtin_amdgcn_readfirstlane((int)selrb[8 + (t >> 5)]);
        const bool a0 = ((ub0 >> (t & 31)) & 1u) != 0u, a1 = ((ub1 >> (t & 31)) & 1u) != 0u;
        const bool dprev = deferred;
        if (dprev) S16_RUN(1, t - 1, pslot);
        if (a0) S16_RUN(0, t, slot);
        deferred = a1 && (a0 || dprev);
        if (a1 && !deferred) S16_RUN(1, t, slot);
        if (it + 1 < nt) S16_WRITE(nslot);
        __syncthreads();
        pslot = slot; slot = nslot;
    }
    if (deferred) S16_RUN(1, nt - 1, pslot);
#undef S16_RUN
#undef S16_ISSUE
#undef S16_WRITE
}
__device__ __forceinline__ void mla_item(LAS unsigned char* lds, unsigned char* ws, int b, int hd, int qb, size_t obase = B_OMLA) {
    const int tid = opaque_tid(), wv = __builtin_amdgcn_readfirstlane(tid >> 6), lane = tid & 63, r = lane & 31, h = lane >> 5;
    const int pos = 256 * qb + 32 * wv + r; const size_t tok = (size_t)b * SEQ + pos;
    const bf16_t* qrow = (const bf16_t*)(ws + B_QM) + tok * 1152 + hd * 192;
    bf16x8 qf[12];
#pragma unroll
    for (int s = 0; s < 12; ++s) qf[s] = *(const GAS bf16x8*)((const GAS bf16_t*)qrow + 16 * s + 8 * h);
    AttnSrc src; src.K = (const bf16_t*)(ws + B_KM) + (size_t)b * SEQ * 1152 + hd * 192; src.ks = 1152; src.V = (const bf16_t*)(ws + B_VM) + (size_t)b * SEQ * 768 + hd * 128; src.vs = 768;
    float m_run = -1e30f, l_run = 0.f; f32x16 O[4]; zero_o<4>(O);
    attn_core<192, 128, 0>(lds, src, 0, 4 * (qb + 1), qf, pos, 0x7fffffffu, 256 * qb + 32 * wv, 256 * qb + 32 * wv + 31, m_run, l_run, O, nullptr, nullptr, 0.f, nullptr, nullptr);
    const float il = l_run > 0.f ? 1.0f / l_run : 0.f;
    store_row<4>((bf16_t*)(ws + obase) + tok * 768 + hd * 128, O, il, h);
}
__device__ __forceinline__ void diff_item(LAS unsigned char* lds, unsigned char* ws, int b, int hd, int qb, float lam, float lam_init, const float* subln) {
    const int tid = opaque_tid(), wv = __builtin_amdgcn_readfirstlane(tid >> 6), lane = tid & 63, r = lane & 31, h = lane >> 5;
    const int pos = 256 * qb + 32 * wv + r; const size_t tok = (size_t)b * SEQ + pos;
    bf16_t* orow = (bf16_t*)(ws + B_ODIFF) + tok * 768 + hd * 192;
#pragma unroll 1
    for (int sub = 0; sub < 2; ++sub) {
        const bf16_t* qrow = (const bf16_t*)(ws + B_DQ) + tok * 768 + (2 * hd + sub) * 96;
        bf16x8 qf[6];
#pragma unroll
        for (int s = 0; s < 6; ++s) qf[s] = *(const GAS bf16x8*)((const GAS bf16_t*)qrow + 16 * s + 8 * h);
        AttnSrc src; src.K = (const bf16_t*)(ws + B_DK) + (size_t)b * SEQ * 768 + (2 * hd + sub) * 96; src.ks = 768; src.V = (const bf16_t*)(ws + B_DV) + (size_t)b * SEQ * 768 + hd * 192; src.vs = 768;
        float m_run = -1e30f, l_run = 0.f; f32x16 O[6]; zero_o<6>(O);
        attn_core<96, 192, 0>(lds, src, 0, 4 * (qb + 1), qf, pos, 0x7fffffffu, 256 * qb + 32 * wv, 256 * qb + 32 * wv + 31, m_run, l_run, O, nullptr, nullptr, 0.f, nullptr, nullptr);
        const float il = l_run > 0.f ? 1.0f / l_run : 0.f;
        if (sub == 0) { store_row<6>(orow, O, il, h); }
        else {
            float ss = 0.f;
#pragma unroll
            for (int db = 0; db < 6; ++db)
#pragma unroll
                for (int i4 = 0; i4 < 4; ++i4) { const u32x2 o = *(const u32x2*)(orow + 32 * db + 8 * i4 + 4 * h);
                    const float a0 = bf_lo(o.x) - lam * O[db][4 * i4] * il, a1 = bf_hi(o.x) - lam * O[db][4 * i4 + 1] * il, a2 = bf_lo(o.y) - lam * O[db][4 * i4 + 2] * il, a3 = bf_hi(o.y) - lam * O[db][4 * i4 + 3] * il;
                    O[db][4 * i4] = a0; O[db][4 * i4 + 1] = a1; O[db][4 * i4 + 2] = a2; O[db][4 * i4 + 3] = a3; ss += (a0 * a0 + a1 * a1) + (a2 * a2 + a3 * a3); }
            ss += __shfl_xor(ss, 32);
            const float rstd = (1.0f / sqrtf(ss * (1.0f / 192.0f) + EPS)) * (1.0f - lam_init);
#pragma unroll
            for (int db = 0; db < 6; ++db)
#pragma unroll
                for (int i4 = 0; i4 < 4; ++i4) { const int d0 = 32 * db + 8 * i4 + 4 * h; const f32x4 g = *(const f32x4*)(subln + d0); u32x2 w;
                    w.x = cvt_pk_bf16(O[db][4 * i4] * rstd * g[0], O[db][4 * i4 + 1] * rstd * g[1]); w.y = cvt_pk_bf16(O[db][4 * i4 + 2] * rstd * g[2], O[db][4 * i4 + 3] * rstd * g[3]);
                    *(u32x2*)(orow + d0) = w; }
        }
    }
}
__device__ __forceinline__ void nsa_item(LAS unsigned char* lds, unsigned char* ws, int b, int qt) {
    const int tid = opaque_tid(), wv = __builtin_amdgcn_readfirstlane(tid >> 6), lane = tid & 63, r = lane & 31, h = lane >> 5;
    const int q0 = 64 * qt, ql = r & 7, hd = r >> 3, pos = q0 + 8 * wv + ql; const size_t tok = (size_t)b * SEQ + pos;
    const int cur = qt;
    const bf16_t* qrow = (const bf16_t*)(ws + B_NQ) + tok * 768 + hd * 192;
    bf16x8 qf[12];
#pragma unroll
    for (int s = 0; s < 12; ++s) qf[s] = *(const GAS bf16x8*)((const GAS bf16_t*)qrow + 16 * s + 8 * h);
    const float* gp = (const float*)(ws + B_NGATE) + tok * 16 + hd * 3;
    const float g_c = gp[0], g_s = gp[1], g_w = gp[2];
    bf16_t* orow = (bf16_t*)(ws + B_ONSA) + tok * 512 + hd * 128;
    LAS float* strip = (LAS float*)(lds + NSA_STRIP_OFF) + wv * (8 * 68);
    LAS float* impw = (LAS float*)(lds + NSA_IMP_OFF) + wv * (8 * 256);
    LAS unsigned* selm = (LAS unsigned*)(lds + NSA_SEL_OFF) + wv * 64;
    LAS unsigned* uni = (LAS unsigned*)(lds + NSA_UNI_OFF) + wv * 8;
    f32x16 O[4];
    const int qc = (pos - 31) >> 4, qc_min = (q0 + 8 * wv - 31) >> 4, qc_max = (q0 + 8 * wv + 7 - 31) >> 4;
    const int jc_hi = ((q0 + 32) >> 10) + 1;
    AttnSrc sc; sc.K = (const bf16_t*)(ws + B_KC) + (size_t)b * 1024 * 192; sc.ks = 192; sc.V = (const bf16_t*)(ws + B_VC) + (size_t)b * 1024 * 128; sc.vs = 128;
    float m_c = -1e30f, l_c = 0.f; zero_o<4>(O);
    attn_core<192, 128, 0>(lds, sc, 0, jc_hi, qf, qc, 0x7fffffffu, qc_min, qc_max, m_c, l_c, O, nullptr, nullptr, 0.f, nullptr, nullptr);
    const float il_c = l_c > 0.f ? 1.0f / l_c : 0.f;
    store_row<4>(orow, O, il_c * g_c, h);
    if (cur >= 16) {
        if (lane < 8) strip[lane * 68 + 3] = 0.f;
        float dm = m_c, dl = 0.f;
        attn_core<192, 128, 2>(lds, sc, 0, jc_hi, qf, qc, 0x7fffffffu, qc_min, qc_max, dm, dl, O, nullptr, nullptr, il_c, strip, impw);
        unsigned un[8] = {0u, 0u, 0u, 0u, 0u, 0u, 0u, 0u};
#pragma unroll 1
        for (int q0_ = 0; q0_ < 8; q0_ += 4) {
            unsigned uk[4][4]; bool cd[4], fl0[4];
#pragma unroll
            for (int k = 0; k < 4; ++k) { const int j = lane + 64 * k; cd[k] = (j >= 1) && (j <= cur - 2); fl0[k] = (j == 0) || (j == cur) || (j == cur - 1);
#pragma unroll
                for (int u = 0; u < 4; ++u) uk[u][k] = cd[k] ? __float_as_uint(impw[(q0_ + u) * 256 + j]) : 0u; }
            unsigned Tv[4] = {0u, 0u, 0u, 0u}; int cv[4] = {1 << 20, 1 << 20, 1 << 20, 1 << 20};
#pragma unroll 1
            for (int bit = 30; bit >= 0; --bit) {
#pragma unroll
                for (int u = 0; u < 4; ++u) { const unsigned Tt = Tv[u] | (1u << bit); int cnt = 0;
#pragma unroll
                    for (int k = 0; k < 4; ++k) cnt += __builtin_popcountll(__ballot(cd[k] && uk[u][k] >= Tt));
                    if (cnt >= 13) { Tv[u] = Tt; cv[u] = cnt; } }
                if (cv[0] == 13 && cv[1] == 13 && cv[2] == 13 && cv[3] == 13) break; }
#pragma unroll
            for (int u = 0; u < 4; ++u) { const int q = q0_ + u; bool fl[4];
#pragma unroll
                for (int k = 0; k < 4; ++k) fl[k] = fl0[k];
                int ngt = 0;
#pragma unroll
                for (int k = 0; k < 4; ++k) ngt += __builtin_popcountll(__ballot(cd[k] && uk[u][k] > Tv[u]));
                int need = 13 - ngt;
#pragma unroll
                for (int k = 0; k < 4; ++k) { const bool eq = cd[k] && uk[u][k] == Tv[u]; const unsigned long long bm = __ballot(eq);
                    const int rank = __builtin_popcountll(bm & ((1ull << lane) - 1ull));
                    if (cd[k] && (uk[u][k] > Tv[u] || (eq && rank < need))) fl[k] = true;
                    need -= __builtin_popcountll(bm); }
#pragma unroll
                for (int k = 0; k < 4; ++k) { const unsigned long long bm = __ballot(fl[k]); const unsigned lo = (unsigned)bm, hi2 = (unsigned)(bm >> 32);
                    if (lane == 0) { selm[q * 8 + 2 * k] = lo; selm[q * 8 + 2 * k + 1] = hi2; } un[2 * k] |= lo; un[2 * k + 1] |= hi2; } }
        }
        if (lane == 0) {
#pragma unroll
            for (int k = 0; k < 8; ++k) uni[k] = un[k]; }
    } else {
        if (lane < 8) {
#pragma unroll
            for (int k = 0; k < 8; ++k) selm[lane * 8 + k] = (k == 0) ? ((1u << (cur + 1)) - 1u) : 0u; }
        if (lane == 0) {
#pragma unroll
            for (int k = 0; k < 8; ++k) uni[k] = (k == 0) ? ((1u << (cur + 1)) - 1u) : 0u; }
    }
    asm volatile("s_waitcnt lgkmcnt(0)" ::: "memory");
    {
        const int c16 = lane & 15, g16 = lane >> 4;
        LAS unsigned* urb = (LAS unsigned*)(lds + NSA_URB_OFF) + wv * 16;
        if (lane < 16) { const int rb_ = lane >> 3, k_ = lane & 7; urb[lane] = (selm[(4 * rb_ + 0) * 8 + k_] | selm[(4 * rb_ + 1) * 8 + k_]) | (selm[(4 * rb_ + 2) * 8 + k_] | selm[(4 * rb_ + 3) * 8 + k_]); }
        asm volatile("s_waitcnt lgkmcnt(0)" ::: "memory");
        AttnSrc ss; ss.K = (const bf16_t*)(ws + B_KSLC) + (size_t)b * SEQ * 192; ss.ks = 192; ss.V = (const bf16_t*)(ws + B_VSLC) + (size_t)b * SEQ * 128; ss.vs = 128;
        bf16x8 q16[2][6]; int qh16[2];
#pragma unroll
        for (int rb = 0; rb < 2; ++rb) { const int ql_ = 4 * rb + (c16 & 3), hd_ = c16 >> 2, pos_ = q0 + 8 * wv + ql_; const size_t tok_ = (size_t)b * SEQ + pos_;
            const GAS bf16_t* qrow_ = (const GAS bf16_t*)(ws + B_NQ) + tok_ * 768 + hd_ * 192;
#pragma unroll
            for (int s = 0; s < 6; ++s) q16[rb][s] = *(const GAS bf16x8*)(qrow_ + 32 * s + 8 * g16);
            qh16[rb] = pos_; }
        float m16[2] = {-1e30f, -1e30f}, l16[2] = {0.f, 0.f}; f32x4 O16[8][2];
#pragma unroll
        for (int db = 0; db < 8; ++db)
#pragma unroll
            for (int rb = 0; rb < 2; ++rb) O16[db][rb] = (f32x4){0.f, 0.f, 0.f, 0.f};
        attn_sel16<192, 128>(lds, ss, cur + 1, q16, qh16, q0 + 8 * wv, selm + (c16 & 3) * 8, selm + (4 + (c16 & 3)) * 8, urb, m16, l16, O16);
        __builtin_amdgcn_fence(__ATOMIC_SEQ_CST, "workgroup");
#pragma unroll
        for (int rb = 0; rb < 2; ++rb) { const int lane_ = opaque_tid() & 63, c_ = lane_ & 15, ql_ = 4 * rb + (c_ & 3), hd_ = c_ >> 2; const size_t tok_ = (size_t)b * SEQ + q0 + 8 * wv + ql_;
            const float sc_ = (l16[rb] > 0.f ? 1.0f / l16[rb] : 0.f) * ((const float*)(ws + B_NGATE))[tok_ * 16 + hd_ * 3 + 1];
            bf16_t* orow_ = (bf16_t*)(ws + B_ONSA) + tok_ * 512 + hd_ * 128 + 4 * (lane_ >> 4);
#pragma unroll
            for (int db = 0; db < 8; ++db) { GAS u32x2* p = (GAS u32x2*)(orow_ + 16 * db); const u32x2 o = *p; u32x2 w;
                w.x = cvt_pk_bf16(bf_lo(o.x) + O16[db][rb][0] * sc_, bf_hi(o.x) + O16[db][rb][1] * sc_);
                w.y = cvt_pk_bf16(bf_lo(o.y) + O16[db][rb][2] * sc_, bf_hi(o.y) + O16[db][rb][3] * sc_); *p = w; } }
        __builtin_amdgcn_fence(__ATOMIC_SEQ_CST, "workgroup");
#pragma unroll
        for (int s = 0; s < 12; ++s) qf[s] = *(const GAS bf16x8*)((const GAS bf16_t*)qrow + 16 * s + 8 * h);
    }
    {
        AttnSrc sw; sw.K = (const bf16_t*)(ws + B_KWIN) + (size_t)b * SEQ * 192; sw.ks = 192; sw.V = (const bf16_t*)(ws + B_VWIN) + (size_t)b * SEQ * 128; sw.vs = 128;
        const int lo = q0 - 511; const int j_lo = lo > 0 ? (lo >> 6) : 0;
        float m_w = -1e30f, l_w = 0.f; zero_o<4>(O);
        attn_core<192, 128, 0>(lds, sw, j_lo, cur + 1, qf, pos, 512u, q0 + 8 * wv, q0 + 8 * wv + 7, m_w, l_w, O, nullptr, nullptr, 0.f, nullptr, nullptr);
        const float il = l_w > 0.f ? 1.0f / l_w : 0.f;
        accum_row<4>(orow, O, il * g_w, h);
    }
}

struct Args { const float* in[29]; float* out; unsigned char* ws; int ph_lo, ph_hi; };
constexpr int PH_PER_LAYER = 15, PH_FINAL = DEPTH * PH_PER_LAYER, PH_TOTAL = PH_FINAL + 1;

__device__ __forceinline__ int q_fetch(unsigned* ctr, volatile LAS unsigned* misc) {
    __syncthreads();
    if (threadIdx.x == 0) misc[4] = __hip_atomic_fetch_add(ctr, 1u, __ATOMIC_RELAXED, __HIP_MEMORY_SCOPE_AGENT);
    __syncthreads();
    return (int)misc[4];
}

__global__ void __launch_bounds__(512, 2) mk_fwd(Args args) {
    extern __shared__ __attribute__((aligned(16))) unsigned char lds_raw[];
    LAS unsigned char* lds = (LAS unsigned char*)lds_raw;
    volatile LAS unsigned* misc = (volatile LAS unsigned*)(lds + MISC_OFF);
    unsigned char* const ws0 = args.ws;
    unsigned* ctl = g_ctl;
    if (threadIdx.x < 16) misc[threadIdx.x] = 0u;
    __syncthreads();
    XcdBarrier bar; bar.bar = ctl + CW_BAR; bar.x = 0; bar.st = misc;
    if (!MK_SPLIT) bar = xcd_barrier_post(ctl + CW_BAR, misc);
    const int lo = args.ph_lo, hi = args.ph_hi;
#ifndef MK_LAST_PHASE
#define MK_LAST_PHASE 1000
#endif
#define IN(k) (lo <= (k) && (k) < hi && ((k) <= MK_LAST_PHASE || (k) == PH_FINAL))
#define SEAM(k) do { if ((k) + 1 < hi) xcd_barrier(bar); } while (0)
    float* xres = args.out;
#define PHASE_LOCALS \
    const int tid = opaque_tid(), lane = tid & 63, wave = __builtin_amdgcn_readfirstlane(tid >> 6); \
    int G = gridDim.x, bx = blockIdx.x; asm volatile("" : "+s"(G), "+s"(bx)); \
    const int gw = bx * 8 + wave, ngw = G * 8; (void)gw; (void)ngw; (void)lane; \
    unsigned char* ws = ws0; asm volatile("" : "+s"(ws)); \
    bf16_t* NB = (bf16_t*)(ws + WS_NBUF); bf16_t* ACT = (bf16_t*)(ws + B_ACT); const float* tab = (const float*)(ws + WS_ROPE); (void)NB; (void)ACT; (void)tab; \
    LAS float* scr = (LAS float*)(lds + wave * 16384); (void)scr; \
    const char __attribute__((address_space(4)))* kargp = (const char __attribute__((address_space(4)))*)__builtin_amdgcn_kernarg_segment_ptr(); asm volatile("" : "+s"(kargp)); (void)kargp;
#define AIN(k) (*(const float* const __attribute__((address_space(4)))*)(kargp + 8 * (k)))

    if (IN(0)) {
        PHASE_LOCALS
        float* tw = (float*)(ws + WS_ROPE);
        for (int i = bx * 512 + tid; i < SEQ * NTAB; i += G * 512) { float c, s; rope_entry(i / NTAB, i % NTAB, c, s); tw[2 * (size_t)i] = c; tw[2 * (size_t)i + 1] = s; }
        u64* stz = (u64*)(ws + WS_STATS);
        for (int i = bx * 512 + tid + T; i < 6 * T; i += G * 512) stz[i] = 0ull;
    }
#pragma unroll 1
    for (int l = 0; l < DEPTH; ++l) {
        const int pb = l * PH_PER_LAYER;
        const float* xin = args.in[0];
        if (IN(pb + 0)) {
            PHASE_LOCALS
            for (int rep_ = 0; rep_ < (int)((DUPMASK >> 0) & 1u) + 1; ++rep_) {
            conv_job(AIN(2) + (size_t)l * D * 2 * DFF, D, 2 * DFF, MAP_FFN_IN, 0, (bf16_t*)(ws + W_FFN_IN), 2 * DFF, scr, gw, ngw, lane, false, AIN(1) + (size_t)l * D);
            conv_job(AIN(3) + (size_t)l * DFF * D, DFF, D, MAP_ID, 0, (bf16_t*)(ws + W_FFN_OUT), D, scr, gw, ngw, lane);
            conv_job(AIN(5) + (size_t)l * D * DIN, D, DIN, MAP_PROJ, 0, (bf16_t*)(ws + W_PROJ), NPROJ, scr, gw, ngw, lane, false, AIN(4) + (size_t)l * D);
            conv_job(AIN(5) + (size_t)l * D * DIN, D, DIN, MAP_GATE, 0, (bf16_t*)(ws + W_GATE), 6144, scr, gw, ngw, lane, false, AIN(4) + (size_t)l * D);
            conv_job(AIN(8) + (size_t)l * 768 * 1152, 768, 1152, MAP_UQ, 0, (bf16_t*)(ws + W_UQ), 1280, scr, gw, ngw, lane);
            conv_job(AIN(9) + (size_t)l * 512 * 1536, 512, 1536, MAP_ID, 0, (bf16_t*)(ws + W_UKV), 1536, scr, gw, ngw, lane);
            conv_job(AIN(11) + (size_t)l * 6144 * 256, 6144, 256, MAP_ID, 0, (bf16_t*)(ws + W_CK1), 256, scr, gw, ngw, lane, true);
            conv_job(AIN(12) + (size_t)l * 256 * 192, 256, 192, MAP_ROPE192, 192, (bf16_t*)(ws + W_CK2), 256, scr, gw, ngw, lane);
            conv_job(AIN(14) + (size_t)l * 4096 * 256, 4096, 256, MAP_ID, 0, (bf16_t*)(ws + W_CV1), 256, scr, gw, ngw, lane);
            conv_job(AIN(15) + (size_t)l * 256 * 128, 256, 128, MAP_PADN, 128, (bf16_t*)(ws + W_CV2), 256, scr, gw, ngw, lane);
            conv_job(AIN(21) + (size_t)l * 768 * D, 768, D, MAP_ID, 0, (bf16_t*)(ws + W_BRM), D, scr, gw, ngw, lane);
            conv_job(AIN(22) + (size_t)l * 512 * D, 512, D, MAP_ID, 0, (bf16_t*)(ws + W_BRN), D, scr, gw, ngw, lane);
            conv_job(AIN(23) + (size_t)l * 768 * D, 768, D, MAP_ID, 0, (bf16_t*)(ws + W_BRD), D, scr, gw, ngw, lane);
            conv_job(AIN(24) + (size_t)l * D * D, D, D, MAP_ID, 0, (bf16_t*)(ws + W_OUT), D, scr, gw, ngw, lane);
            if (l == 0) { u64* st0 = (u64*)(ws + WS_STATS); for (int mrow = gw; mrow < T; mrow += ngw) xb_row_stats(xin + (size_t)mrow * D, NB + (size_t)mrow * D, st0 + mrow, lane); }
            if (bx < 64) {
                float* part = (float*)(ws + WS_BIASP);
                const int isv = tid >> 8, n = tid & 255;
                const int rows = isv ? 64 : 96; const int r0 = bx * rows;
                const float* pp = (isv ? AIN(13) + (size_t)l * 4096 : AIN(10) + (size_t)l * 6144) + r0;
                const float* wp = (isv ? AIN(14) + (size_t)l * 4096 * 256 : AIN(11) + (size_t)l * 6144 * 256) + (size_t)r0 * 256 + n;
                float a = 0.f;
                for (int rr = 0; rr < rows; ++rr) a += pp[rr] * wp[(size_t)rr * 256];
                part[(isv * 64 + bx) * 256 + n] = a;
            }
            }
            SEAM(pb + 0);
        }
        if (IN(pb + 1)) {
            PHASE_LOCALS
            for (int rep_ = 0; rep_ < (int)((DUPMASK >> 1) & 1u) + 1; ++rep_) {
            pg8::Gemm g{NB, (const bf16_t*)(ws + W_FFN_IN), T, 2 * DFF, D, D, D}; pg8::StaticOrder S; S.init(T, 2 * DFF, G, bx);
            EpiSwiglu E{ACT, DFF, (const u64*)(ws + WS_STATS) + (size_t)(l * 3 + 0) * T};
            pg8::gemm_phase<EpiSwiglu, pg8::StaticOrder>(lds, g, S, E);
            }
            SEAM(pb + 1);
        }
        if (IN(pb + 2)) {
            PHASE_LOCALS
            for (int rep_ = 0; rep_ < (int)((DUPMASK >> 2) & 1u) + 1; ++rep_) {
            pg8::Gemm g{ACT, (const bf16_t*)(ws + W_FFN_OUT), T, D, DFF, DFF, DFF}; pg8::StaticOrder S; S.init(T, D, G, bx);
            EpiResid E{NB, 0.5f, (u64*)(ws + WS_STATS) + (size_t)(l * 3 + 1) * T};
            pg8::gemm_phase<EpiResid, pg8::StaticOrder>(lds, g, S, E);
            }
            SEAM(pb + 2);
        }
        if (IN(pb + 4)) {
            PHASE_LOCALS
            for (int rep_ = 0; rep_ < (int)((DUPMASK >> 4) & 1u) + 1; ++rep_) {
            pg8::Gemm g{NB, (const bf16_t*)(ws + W_PROJ), T, NPROJ, D, D, D}; pg8::StaticOrder S; S.init(T, NPROJ, G, bx);
            EpiProj E{ws, tab, (const u64*)(ws + WS_STATS) + (size_t)(l * 3 + 1) * T};
            pg8::gemm_phase<EpiProj, pg8::StaticOrder>(lds, g, S, E);
            }
            SEAM(pb + 4);
        }
        if (IN(pb + 5)) {
            PHASE_LOCALS
            for (int rep_ = 0; rep_ < (int)((DUPMASK >> 5) & 1u) + 1; ++rep_) {
            conv_job(AIN(26) + (size_t)l * D * 2 * DFF, D, 2 * DFF, MAP_FFN_IN, 0, (bf16_t*)(ws + W_FFN_IN), 2 * DFF, scr, gw, ngw, lane, false, AIN(25) + (size_t)l * D);
            conv_job(AIN(27) + (size_t)l * DFF * D, DFF, D, MAP_ID, 0, (bf16_t*)(ws + W_FFN_OUT), D, scr, gw, ngw, lane);
            for (int i = bx * 512 + tid; i < 16 * 192; i += G * 512) ((bf16_t*)(ws + B_KCMP))[(size_t)T * 192 + i] = 0;
            for (int i = bx * 512 + tid; i < 16 * 128; i += G * 512) ((bf16_t*)(ws + B_VCMP))[(size_t)T * 128 + i] = 0;
            for (int mrow = gw; mrow < T; mrow += ngw) {
                rms_row_inplace_bf16<768>((bf16_t*)(ws + B_CQ) + (size_t)mrow * 768, AIN(6) + (size_t)l * 768, lane);
                rms_row_inplace_bf16<512>((bf16_t*)(ws + B_CKV) + (size_t)mrow * 512, AIN(7) + (size_t)l * 512, lane);
            }
            if (bx == 0) { const float* part = (const float*)(ws + WS_BIASP); float* bias = (float*)(ws + WS_BIASP) + 2 * 64 * 256;
                const int isv = tid >> 8, n = tid & 255; float a = 0.f;
                for (int j = 0; j < 64; ++j) a += part[(isv * 64 + j) * 256 + n];
                bias[isv * 256 + n] = a; }
            }
            SEAM(pb + 5);
        }
        if (IN(pb + 6)) {
            PHASE_LOCALS
            for (int rep_ = 0; rep_ < (int)((DUPMASK >> 6) & 1u) + 1; ++rep_) {
            if (bx < 16 && G > 16) {
                const bool isv = bx >= 8; const int c8 = bx & 7;
                const float* bias = (const float*)(ws + WS_BIASP) + 2 * 64 * 256 + (isv ? 256 : 0);
                { pg8::Gemm g{(const bf16_t*)(ws + (isv ? B_VCMP : B_KCMP)), (const bf16_t*)(ws + (isv ? W_CV1 : W_CK1)), 2048, 256, isv ? 4096 : 6144, isv ? 16 * 128 : 16 * 192, isv ? 4096 : 6144};
                  pg8::StaticOrder S; S.init(2048, 256, 8, c8);
                  EpiBf16<2> E{(bf16_t*)(ws + (isv ? B_HIDV : B_HIDK)), 256, 256, bias, nullptr}; pg8::gemm_phase<EpiBf16<2>, pg8::StaticOrder>(lds, g, S, E); }
                { pg8::Gemm g{(const bf16_t*)(ws + (isv ? B_HIDV : B_HIDK)), (const bf16_t*)(ws + (isv ? W_CV2 : W_CK2)), 2048, 256, 256, 256, 256};
                  pg8::StaticOrder S; S.init(2048, 256, 8, c8);
                  EpiBf16<0> E{(bf16_t*)(ws + (isv ? B_VC : B_KC)), isv ? 128 : 192, isv ? 128 : 192, nullptr, nullptr}; pg8::gemm_phase<EpiBf16<0>, pg8::StaticOrder>(lds, g, S, E); }
            } else {
                const int Gm = (G > 16) ? G - 16 : G, cm = (G > 16) ? bx - 16 : bx;
                { pg8::Gemm g{(const bf16_t*)(ws + B_CQ), (const bf16_t*)(ws + W_UQ), T, 1280, 768, 768, 768}; pg8::StaticOrder S; S.init(T, 1280, Gm, cm);
                  EpiUq E{(bf16_t*)(ws + B_QM), tab}; pg8::gemm_phase<EpiUq, pg8::StaticOrder>(lds, g, S, E); }
                { pg8::Gemm g{(const bf16_t*)(ws + B_CKV), (const bf16_t*)(ws + W_UKV), T, 1536, 512, 512, 512}; pg8::StaticOrder S; S.init(T, 1536, Gm, cm);
                  EpiUkv E{(bf16_t*)(ws + B_KM), (bf16_t*)(ws + B_VM)}; pg8::gemm_phase<EpiUkv, pg8::StaticOrder>(lds, g, S, E); }
            }
            }
            SEAM(pb + 6);
        }
        if (IN(pb + 8)) {
            PHASE_LOCALS
            for (int rep_ = 0; rep_ < (int)((DUPMASK >> 8) & 1u) + 1; ++rep_) {
            float s1 = 0.f, s2 = 0.f;
            { const float* a1 = AIN(16) + l * 96; const float* b1 = AIN(17) + l * 96; const float* a2 = AIN(18) + l * 96; const float* b2 = AIN(19) + l * 96;
              for (int i = 0; i < 96; ++i) { s1 += a1[i] * b1[i]; s2 += a2[i] * b2[i]; } }
            const float lam_init = (l == 0) ? 0.2f : 0.35550906759096934f;
            const float lam = __builtin_amdgcn_exp2f(s1 * LOG2E) - __builtin_amdgcn_exp2f(s2 * LOG2E) + lam_init;
#ifndef DUP8
#define DUP8 1
#endif
#pragma unroll 1
            for (int rep = 0; rep < DUP8; ++rep) {
            unsigned* qd = ctl + CW_Q + 64 * (rep * 8 + l * 4 + 0); unsigned* qm = ctl + CW_Q + 64 * (rep * 8 + l * 4 + 1); unsigned* qn = ctl + CW_Q + 64 * (rep * 8 + l * 4 + 2);
#ifndef ONLY_MASK
#define ONLY_MASK 7
#endif
#ifdef STATIC_Q
#define QF(ctr, k_) (bx + (k_) * G)
#else
#define QF(ctr, k_) q_fetch(ctr, misc)
#endif
            for (int kq = 0;; ++kq) { const int idx = QF(qn, kq); if (idx >= 2 * 256 || ((rep == 0 ? ONLY_MASK : REP2_MASK) & 4) == 0) break;
                const int qt = 255 - idx / 2, b = idx % 2; nsa_item(lds, ws, b, qt); }
            for (int kq = 0;; ++kq) { const int idx = QF(qd, kq); if (idx >= 8 * 64 || ((rep == 0 ? ONLY_MASK : REP2_MASK) & 1) == 0) break;
                const int qb = 63 - idx / 8, bh = idx % 8; diff_item(lds, ws, bh >> 2, bh & 3, qb, lam, lam_init, AIN(20) + (size_t)l * 192); }
            for (int kq = 0;; ++kq) { const int idx = QF(qm, kq); if (idx >= 12 * 64 || ((rep == 0 ? ONLY_MASK : REP2_MASK) & 2) == 0) break;
                const int qb = 63 - idx / 12, bh = idx % 12; mla_item(lds, ws, bh / 6, bh % 6, qb); }
#ifdef DBG_TWICE
            for (int kq = 0;; ++kq) { const int idx = QF(qm, kq); if (idx >= 12 * 64) break;
                const int qb = 63 - idx / 12, bh = idx % 12; mla_item(lds, ws, bh / 6, bh % 6, qb, B_ODIFF); }
#endif
            __syncthreads();
            }
            }
            SEAM(pb + 8);
        }
        if (IN(pb + 9)) {
            PHASE_LOCALS
            for (int rep_ = 0; rep_ < (int)((DUPMASK >> 9) & 1u) + 1; ++rep_) {
            pg8::Gemm g{NB, (const bf16_t*)(ws + W_GATE), T, 6144, D, D, D}; pg8::StaticOrder S; S.init(T, 6144, G, bx);
            EpiBf16<1> E{(bf16_t*)(ws + B_G), 6144, 6144, nullptr, (const u64*)(ws + WS_STATS) + (size_t)(l * 3 + 1) * T};
            pg8::gemm_phase<EpiBf16<1>, pg8::StaticOrder>(lds, g, S, E);
            }
            SEAM(pb + 9);
        }
        if (IN(pb + 10)) {
            PHASE_LOCALS
            for (int rep_ = 0; rep_ < (int)((DUPMASK >> 10) & 1u) + 1; ++rep_) {
#ifndef BR_MASK
#define BR_MASK 7
#endif
            if (BR_MASK & 1) { pg8::Gemm g{(const bf16_t*)(ws + B_OMLA), (const bf16_t*)(ws + W_BRM), T, D, 768, 768, 768}; pg8::StaticOrder S; S.init(T, D, G, bx);
              EpiBranch E{(bf16_t*)(ws + WS_MIXB), (const bf16_t*)(ws + B_G), 0, 1}; pg8::gemm_phase<EpiBranch, pg8::StaticOrder>(lds, g, S, E); }
            if (BR_MASK & 2) { pg8::Gemm g{(const bf16_t*)(ws + B_ONSA), (const bf16_t*)(ws + W_BRN), T, D, 512, 512, 512}; pg8::StaticOrder S; S.init(T, D, G, bx);
              EpiBranch E{(bf16_t*)(ws + WS_MIXB), (const bf16_t*)(ws + B_G), 2048, (BR_MASK & 1) ? 0 : 1}; pg8::gemm_phase<EpiBranch, pg8::StaticOrder>(lds, g, S, E); }
            if (BR_MASK & 4) { pg8::Gemm g{(const bf16_t*)(ws + B_ODIFF), (const bf16_t*)(ws + W_BRD), T, D, 768, 768, 768}; pg8::StaticOrder S; S.init(T, D, G, bx);
              EpiBranch E{(bf16_t*)(ws + WS_MIXB), (const bf16_t*)(ws + B_G), 4096, (BR_MASK & 3) ? 0 : 1}; pg8::gemm_phase<EpiBranch, pg8::StaticOrder>(lds, g, S, E); }
            }
            SEAM(pb + 10);
        }
        if (IN(pb + 11)) {
            PHASE_LOCALS
            for (int rep_ = 0; rep_ < (int)((DUPMASK >> 11) & 1u) + 1; ++rep_) {
            pg8::Gemm g{(const bf16_t*)(ws + WS_MIXB), (const bf16_t*)(ws + W_OUT), T, D, D, D, D}; pg8::StaticOrder S; S.init(T, D, G, bx);
            EpiResid E{NB, 1.0f, (u64*)(ws + WS_STATS) + (size_t)(l * 3 + 2) * T};
            pg8::gemm_phase<EpiResid, pg8::StaticOrder>(lds, g, S, E);
            }
            SEAM(pb + 11);
        }
        if (IN(pb + 13)) {
            PHASE_LOCALS
            for (int rep_ = 0; rep_ < (int)((DUPMASK >> 13) & 1u) + 1; ++rep_) {
            pg8::Gemm g{NB, (const bf16_t*)(ws + W_FFN_IN), T, 2 * DFF, D, D, D}; pg8::StaticOrder S; S.init(T, 2 * DFF, G, bx);
            EpiSwiglu E{ACT, DFF, (const u64*)(ws + WS_STATS) + (size_t)(l * 3 + 2) * T};
            pg8::gemm_phase<EpiSwiglu, pg8::StaticOrder>(lds, g, S, E);
            }
            SEAM(pb + 13);
        }
        if (IN(pb + 14)) {
            PHASE_LOCALS
            for (int rep_ = 0; rep_ < (int)((DUPMASK >> 14) & 1u) + 1; ++rep_) {
            pg8::Gemm g{ACT, (const bf16_t*)(ws + W_FFN_OUT), T, D, DFF, DFF, DFF}; pg8::StaticOrder S; S.init(T, D, G, bx);
            const bool more = (l + 1 < DEPTH);
            EpiResid E{NB, 0.5f, more ? (u64*)(ws + WS_STATS) + (size_t)((l + 1) * 3 + 0) * T : nullptr};
            pg8::gemm_phase<EpiResid, pg8::StaticOrder>(lds, g, S, E);
            }
            SEAM(pb + 14);
        }
    }
    if (IN(PH_FINAL)) {
        PHASE_LOCALS
#ifdef DBG_DUMP
        for (size_t i = (size_t)bx * 512 + tid; i < (size_t)T * D; i += (size_t)G * 512) { const size_t t = i / D; const int c = (int)(i % D);
            float v = 0.f;
            if (c < 768) { const float a = __uint_as_float(((unsigned)((const bf16_t*)(ws + B_OMLA))[t * 768 + c]) << 16); v = (a - a == 0.f) ? 0.f : __builtin_ldexpf(1.0f, DBG_ENC); }
            xres[i] = v; }
#else
        for (int mrow = gw; mrow < T; mrow += ngw) rms_row_out(NB + (size_t)mrow * D, xres + (size_t)mrow * D, AIN(28), lane);
#endif
    }
#undef IN
#undef SEAM
    __syncthreads();
    if (threadIdx.x == 0) misc[5] = (__hip_atomic_fetch_add(ctl + CW_EXIT, 1u, __ATOMIC_RELAXED, __HIP_MEMORY_SCOPE_AGENT) == gridDim.x - 1u) ? 1u : 0u;
    __syncthreads();
    if (misc[5] != 0u) { for (int i = threadIdx.x; i < CTL_WORDS; i += 512) __hip_atomic_store(ctl + i, 0u, __ATOMIC_RELAXED, __HIP_MEMORY_SCOPE_AGENT); }
}

extern "C" void kernel_launch(void* const* d_in, const int* in_sizes, int n_in, void* d_out, int out_size, void* d_ws, size_t ws_size, hipStream_t stream) {
    static int grid = 0;
    if (grid == 0) {
        if (n_in != 29 || in_sizes[0] != T * D || out_size != T * D || ws_size < WS_END) {
            fprintf(stderr, "kernel_launch: unexpected shapes (n_in %d, in0 %d, out %d, ws %zu, need %zu); nothing launched\n", n_in, n_in > 0 ? in_sizes[0] : -1, out_size, ws_size, (size_t)WS_END);
            grid = -1; return; }
        int dev = 0, cus = 0, per_cu = 0;
        if (hipGetDevice(&dev) != hipSuccess || hipDeviceGetAttribute(&cus, hipDeviceAttributeMultiprocessorCount, dev) != hipSuccess) { grid = -1; return; }
        if (hipFuncSetAttribute((const void*)mk_fwd, hipFuncAttributeMaxDynamicSharedMemorySize, LDS_BYTES) != hipSuccess) { fprintf(stderr, "kernel_launch: hipFuncSetAttribute failed\n"); grid = -1; return; }
        if (hipOccupancyMaxActiveBlocksPerMultiprocessor(&per_cu, (const void*)mk_fwd, 512, LDS_BYTES) != hipSuccess || per_cu < 1)
            fprintf(stderr, "kernel_launch: occupancy query reports %d workgroups per CU\n", per_cu);
        (void)hipGetLastError();
        grid = cus;
    }
    if (grid < 0) return;
    Args a{};
    for (int i = 0; i < 29; ++i) a.in[i] = (const float*)d_in[i];
    a.out = (float*)d_out; a.ws = (unsigned char*)d_ws;
#if MK_SPLIT
#ifndef MK_LAST_PHASE
#define MK_LAST_PHASE 1000
#endif
    for (int p = 0; p < PH_TOTAL; ++p) { if (p > MK_LAST_PHASE && p != PH_FINAL) continue; a.ph_lo = p; a.ph_hi = p + 1; hipLaunchKernelGGL(mk_fwd, dim3(grid), dim3(512), LDS_BYTES, stream, a); }
#else
    a.ph_lo = 0; a.ph_hi = PH_TOTAL;
    hipLaunchKernelGGL(mk_fwd, dim3(grid), dim3(512), LDS_BYTES, stream, a);
#endif
    const hipError_t le = hipPeekAtLastError();
    if (le != hipSuccess) fprintf(stderr, "kernel_launch: launch failed: %s\n", hipGetErrorName(le));
}
```

```cpp
#include <hip/hip_runtime.h>
#include <cstdio>
#include <cstdint>

#define GAS __attribute__((address_space(1)))
#define LAS __attribute__((address_space(3)))
typedef unsigned short bf16_t;
typedef short bf16x8 __attribute__((ext_vector_type(8)));
typedef short s16x4 __attribute__((ext_vector_type(4)));
typedef float f32x4 __attribute__((ext_vector_type(4)));
typedef float f32x16 __attribute__((ext_vector_type(16)));
typedef unsigned u32x4 __attribute__((ext_vector_type(4)));
typedef unsigned u32x2 __attribute__((ext_vector_type(2)));
typedef unsigned long long u64;
constexpr float STAT_FIX = 4294967296.0f;

#ifndef REP2_MASK
#define REP2_MASK 7
#endif
#ifndef DUPMASK
#define DUPMASK 0u
#endif
#ifndef MK_SPLIT
#define MK_SPLIT 0
#endif

constexpr int D = 2048, SEQ = 16384, BATCH = 2, T = BATCH * SEQ, DFF = 5632, DIN = 11532, DEPTH = 2;
constexpr int NPROJ = 5632;
constexpr float EPS = 1e-6f;
constexpr float QS192 = 0.10411754627697264f;
constexpr float QS96 = 0.14724444602590306f;
constexpr float LOG2E = 1.4426950408889634f;
constexpr int NTAB = 176;

constexpr size_t MiB = 1u << 20;
constexpr size_t WS_CTL = 0, CTL_BYTES = 1 * MiB;
constexpr size_t WS_BIASP = 1 * MiB;
constexpr size_t WS_ROPE = 2 * MiB;
constexpr size_t WS_W = 24 * MiB;
constexpr size_t W_FFN_IN = WS_W, W_FFN_OUT = W_FFN_IN + 44 * MiB, W_PROJ = W_FFN_OUT + 22 * MiB, W_GATE = W_PROJ + 22 * MiB,
                 W_UQ = W_GATE + 24 * MiB, W_UKV = W_UQ + 2 * MiB, W_CK1 = W_UKV + 2 * MiB, W_CV1 = W_CK1 + 3 * MiB, W_CK2 = W_CV1 + 2 * MiB,
                 W_CV2 = W_CK2 + (MiB / 2), W_BRM = W_CV2 + (MiB / 2), W_BRN = W_BRM + 3 * MiB, W_BRD = W_BRN + 2 * MiB, W_OUT = W_BRD + 3 * MiB,
                 WS_WEND = W_OUT + 8 * MiB;
constexpr size_t WS_NBUF = WS_WEND;
constexpr size_t WS_BIG = WS_NBUF + 128 * MiB;
constexpr size_t B_ACT = WS_BIG;
constexpr size_t B_CQ = WS_BIG, B_CKV = B_CQ + 48 * MiB;
constexpr size_t B_OMLA = WS_BIG, B_ONSA = B_OMLA + 48 * MiB, B_ODIFF = B_ONSA + 32 * MiB;
constexpr size_t B_QM = WS_BIG + 128 * MiB, B_KM = B_QM + 72 * MiB, B_VM = B_KM + 72 * MiB, B_NQ = B_VM + 48 * MiB,
                 B_KCMP = B_NQ + 48 * MiB, B_VCMP = B_KCMP + 13 * MiB, B_KSLC = B_VCMP + 9 * MiB, B_VSLC = B_KSLC + 12 * MiB,
                 B_KWIN = B_VSLC + 8 * MiB, B_VWIN = B_KWIN + 12 * MiB, B_NGATE = B_VWIN + 8 * MiB, B_DQ = B_NGATE + 2 * MiB,
                 B_DK = B_DQ + 48 * MiB, B_DV = B_DK + 48 * MiB, B_HIDK = B_DV + 48 * MiB, B_HIDV = B_HIDK + 1 * MiB,
                 B_KC = B_HIDV + 1 * MiB, B_VC = B_KC + 1 * MiB, B_END = B_VC + 1 * MiB;
constexpr size_t WS_STATS = B_END;
constexpr size_t WS_MIXB = WS_STATS + 2 * MiB;
constexpr size_t B_G = B_QM;
static_assert(B_G + 384 * MiB <= B_END + 64 * MiB, "G overlay");
constexpr size_t WS_END = WS_MIXB + 128 * MiB;
static_assert(B_END >= B_ACT + 352 * MiB && B_END >= B_G + 384 * MiB, "workspace map");
constexpr int CW_BAR = 0;
constexpr int CW_Q = 4096;
constexpr int CW_EXIT = 8192;
constexpr int CTL_WORDS = 8256;
__device__ unsigned g_ctl[CTL_WORDS];

constexpr int LDS_BYTES = 163840;
constexpr int RING_BYTES = 131072;
constexpr int NSA_STRIP_OFF = 116736, NSA_SEL_OFF = 134144, NSA_UNI_OFF = 136192;
constexpr int NSA_URB_OFF = 136448;
constexpr int NSA_IMP_OFF = 51200;
constexpr int MISC_OFF = 163840 - 256;

typedef float f32x2_t __attribute__((ext_vector_type(2)));
typedef __bf16 bf16x2_t __attribute__((ext_vector_type(2)));
__device__ __forceinline__ unsigned cvt_pk_bf16(float lo, float hi) { const f32x2_t v = {lo, hi}; const bf16x2_t b = __builtin_convertvector(v, bf16x2_t); return __builtin_bit_cast(unsigned, b); }
__device__ __forceinline__ u32x4 pack8f(f32x4 a, f32x4 b) { u32x4 w; w.x = cvt_pk_bf16(a[0], a[1]); w.y = cvt_pk_bf16(a[2], a[3]); w.z = cvt_pk_bf16(b[0], b[1]); w.w = cvt_pk_bf16(b[2], b[3]); return w; }
__device__ __forceinline__ float bf_lo(unsigned u) { return __uint_as_float(u << 16); }
__device__ __forceinline__ float bf_hi(unsigned u) { return __uint_as_float(u & 0xffff0000u); }
__device__ __forceinline__ float wave_sum(float v) {
#pragma unroll
    for (int o = 1; o < 64; o <<= 1) v += __shfl_xor(v, o);
    return v;
}
__device__ __forceinline__ int opaque_tid() { int t = threadIdx.x; asm volatile("" : "+v"(t)); return t; }
__device__ __forceinline__ float fast_sigmoid(float x) { return __builtin_amdgcn_rcpf(1.0f + __builtin_amdgcn_exp2f(-x * LOG2E)); }

#define XB_TMO      128
#define XB_XCNT(j)  (256  + 64 * (j))
#define XB_XSUB(j)  (1280 + 64 * (j))
#define XB_XGEN(j)  (2304 + 64 * (j))
#define XB_TOP      3328
#define XB_TOPGEN   3392
#define XCD_BAR_WORDS 3456
#define XB_SPIN_CAP (1u << 22)
__device__ __forceinline__ unsigned xb_ld(unsigned* p)              { return __hip_atomic_load(p, __ATOMIC_RELAXED, __HIP_MEMORY_SCOPE_AGENT); }
__device__ __forceinline__ unsigned xb_add(unsigned* p, unsigned v) { return __hip_atomic_fetch_add(p, v, __ATOMIC_RELAXED, __HIP_MEMORY_SCOPE_AGENT); }
__device__ __forceinline__ unsigned xb_xcc_id() { return (unsigned)__builtin_amdgcn_s_getreg((3 << 11) | 20) & 0xFu; }
#define XB_SPIN(cond, bar) do { unsigned _sp = 0; while (cond) { __builtin_amdgcn_s_sleep(1); \
    if ((++_sp & 255u) == 0u) { if (xb_ld(&(bar)[XB_TMO])) break; if (_sp > XB_SPIN_CAP) { atomicAdd(&(bar)[XB_TMO], 1u); break; } } } } while (0)
struct XcdBarrier { unsigned* bar; unsigned x; volatile LAS unsigned* st; };
__device__ __forceinline__ XcdBarrier xcd_barrier_post(unsigned* bar, volatile LAS unsigned* st) {
    XcdBarrier b; b.bar = bar; b.x = xb_xcc_id(); b.st = st;
    if (threadIdx.x == 0) (void)xb_add(&bar[XB_XCNT(b.x)], 1u);
    return b;
}
__device__ __forceinline__ void xcd_barrier_complete(unsigned* bar, unsigned x, unsigned& nloc, unsigned& nx) {
    const unsigned G = gridDim.x * gridDim.y * gridDim.z;
    unsigned sum, cnt, mine, sp = 0u;
    for (;;) {
        sum = 0u; cnt = 0u; mine = 0u;
#pragma unroll
        for (unsigned j = 0; j < 16; ++j) { const unsigned c = xb_ld(&bar[XB_XCNT(j)]); sum += c; cnt += (c > 0u) ? 1u : 0u; mine = (j == x) ? c : mine; }
        if (sum == G) break;
        __builtin_amdgcn_s_sleep(1);
        if ((++sp & 255u) == 0u) { if (xb_ld(&bar[XB_TMO])) break; if (sp > XB_SPIN_CAP) { atomicAdd(&bar[XB_TMO], 1u); break; } }
    }
    nloc = mine > 0u ? mine : 1u; nx = cnt > 0u ? cnt : 1u;
}
__device__ __forceinline__ void xcd_barrier(const XcdBarrier& b) {
    asm volatile("s_waitcnt vmcnt(0)" ::: "memory");
    __syncthreads();
    if (threadIdx.x == 0) {
        unsigned* bar = b.bar;
        __builtin_amdgcn_s_waitcnt(0);
        unsigned nloc = b.st[0], nx = b.st[1];
        if (nloc == 0u) { xcd_barrier_complete(bar, b.x, nloc, nx); b.st[0] = nloc; b.st[1] = nx; }
        const unsigned old = xb_add(&bar[XB_XSUB(b.x)], 1u);
        const unsigned gen = old / nloc;
        if (old + 1u == (gen + 1u) * nloc) {
            __builtin_amdgcn_fence(__ATOMIC_RELEASE, "agent");
            asm volatile("s_waitcnt vmcnt(0)" ::: "memory");
            const unsigned og = xb_add(&bar[XB_TOP], 1u);
            const unsigned tg = og / nx;
            if (og + 1u == (tg + 1u) * nx) xb_add(&bar[XB_TOPGEN], 1u);
            else XB_SPIN(xb_ld(&bar[XB_TOPGEN]) == tg, bar);
            __builtin_amdgcn_fence(__ATOMIC_ACQUIRE, "agent");
            xb_add(&bar[XB_XGEN(b.x)], 1u);
            asm volatile("s_waitcnt vmcnt(0)" ::: "memory");
        } else {
            XB_SPIN(xb_ld(&bar[XB_XGEN(b.x)]) == gen, bar);
            __builtin_amdgcn_fence(__ATOMIC_ACQUIRE, "agent");
            asm volatile("s_waitcnt vmcnt(0)" ::: "memory");
        }
    }
    __syncthreads();
}

namespace pg8 {
constexpr int BM = 256, BK = 64, HALF = 128, HTB = HALF * BK * 2, STAGE_BYTES = 8 * HTB, NXCD = 8, WGM = 4;
__host__ __device__ __forceinline__ int lds_byte(int r, int c) { const int st = (r >> 4) * 2 + (c >> 5), rr = r & 15, cc = c & 31, ob = rr * 64 + cc * 2; return st * 1024 + (ob ^ (((ob >> 9) & 1) << 5)); }
__host__ __device__ __forceinline__ void stage_rc(int b, int& R, int& C) { const int st = b / 1024, sb = b % 1024, swz = sb ^ (((sb >> 9) & 1) << 5); R = (st >> 1) * 16 + swz / 64; C = (st & 1) * 32 + (swz % 64) / 2; }
__host__ __device__ __forceinline__ int perm32(int rho) { const int n = rho >> 4, i = rho & 15; return 8 * (i >> 2) + 4 * n + (i & 3); }
struct Unit { int pm, pn; };
struct Gemm { const bf16_t* A; const bf16_t* Bt; int M, N, K, lda, ldb; };
struct StaticOrder {
    int nM, nN, nwg, G, c;
    __host__ __device__ void init(int M, int N, int G_, int c_) { nM = M / BM; nN = N / BM; nwg = nM * nN; G = G_; c = c_; }
    __host__ __device__ bool next(int i, Unit& u) const {
        const long L = (long)i * G + c; if (L >= nwg) return false;
        int wgid = (int)L; { const int q = nwg / NXCD, r = nwg % NXCD, xcd = wgid % NXCD, off = wgid / NXCD; wgid = (xcd < r ? xcd * (q + 1) : r * (q + 1) + (xcd - r) * q) + off; }
        const int nig = WGM * nN, gid = wgid / nig, fm = gid * WGM, gsz = (nM - fm) < WGM ? (nM - fm) : WGM;
        u.pm = fm + ((wgid % nig) % gsz); u.pn = (wgid % nig) / gsz; return true;
    }
    __device__ __forceinline__ void a_ready(const Unit&) const {}
    __device__ __forceinline__ void done(const Unit&) const {}
};
template <class Epi, class Sched, bool ALIGN_EPI = true, bool SP2 = true>
__device__ __forceinline__ void gemm_phase(LAS unsigned char* lds, const Gemm g, const Sched& S, const Epi& E) {
    const int tid = opaque_tid(), wid = __builtin_amdgcn_readfirstlane(tid >> 6), lane = tid & 63, wr = wid >> 2, wc = wid & 3, fr = lane & 15, fq = lane >> 4;
    const int K = g.K, nt = K / BK;
    unsigned voffA[2], voffB[2];
#pragma unroll
    for (int i = 0; i < 2; ++i) { int R, C; stage_rc(tid * 16 + i * 8192, R, C); const int Rb = Epi::PERM ? ((R & ~31) + perm32(R & 31)) : R;
        voffA[i] = (unsigned)(R * g.lda + C) * 2u; voffB[i] = (unsigned)(Rb * g.ldb + C) * 2u; }
    const size_t kstep = (size_t)(BK * 2);
    const size_t hstepA = (size_t)HALF * g.lda * 2, hstepB = (size_t)HALF * g.ldb * 2;
    const size_t tstepA = 2 * hstepA, tstepB = 2 * hstepB;
    const unsigned ldsw = (unsigned)wid * 1024u;
    const int aoff = lds_byte(wr * 64 + fr, fq * 8), boff = lds_byte(wc * 32 + fr, fq * 8);
#define PG8_SA(b, h) (((b) * 2 + (h)) * HTB)
#define PG8_SB(b, h) ((4 + (b) * 2 + (h)) * HTB)
#define PG8_STAGE(bufoff, gbase, voff) do { _Pragma("unroll") for (int _i = 0; _i < 2; ++_i) \
        __builtin_amdgcn_global_load_lds((const unsigned*)((const char*)(gbase) + (voff)[_i]), (LAS unsigned*)(lds + (bufoff) + ldsw + _i * 8192), 16, 0, 0); } while (0)
#define PG8_LDA(dst, b, h) do { _Pragma("unroll") for (int m = 0; m < 4; ++m) _Pragma("unroll") for (int k = 0; k < 2; ++k) dst[m][k] = *(const LAS bf16x8*)(lds + PG8_SA(b, h) + aoff + m * 2048 + k * 1024); } while (0)
#define PG8_LDB(dst, b, h) do { _Pragma("unroll") for (int n = 0; n < 2; ++n) _Pragma("unroll") for (int k = 0; k < 2; ++k) dst[n][k] = *(const LAS bf16x8*)(lds + PG8_SB(b, h) + boff + n * 2048 + k * 1024); } while (0)
#define PG8_MMA(ai, bj, At, Bt) do { __builtin_amdgcn_s_setprio(1); _Pragma("unroll") for (int m = 0; m < 4; ++m) _Pragma("unroll") for (int n = 0; n < 2; ++n) _Pragma("unroll") for (int k = 0; k < 2; ++k) \
        acc[ai][bj][m][n] = __builtin_amdgcn_mfma_f32_16x16x32_bf16(Bt[n][k], At[m][k], acc[ai][bj][m][n], 0, 0, 0); __builtin_amdgcn_s_setprio(0); } while (0)
#define PG8_WAIT_V(n) asm volatile("s_waitcnt vmcnt(" #n ")" ::: "memory")
#define PG8_WAIT_L(n) asm volatile("s_waitcnt lgkmcnt(" #n ")" ::: "memory")
#define PG8_BAR __builtin_amdgcn_s_barrier()
#define PG8_SCHED __builtin_amdgcn_sched_barrier(0)
    Unit cur, nxt; int ui = 0;
    if (!S.next(0, cur)) return;
    f32x4 acc[2][2][4][2];
#pragma unroll
    for (int a = 0; a < 2; ++a)
#pragma unroll
        for (int b = 0; b < 2; ++b)
#pragma unroll
            for (int m = 0; m < 4; ++m)
#pragma unroll
                for (int n = 0; n < 2; ++n) acc[a][b][m][n] = (f32x4){0.f, 0.f, 0.f, 0.f};
    bf16x8 At[4][2], B0[2][2], B1[2][2];
    const char* cA = (const char*)g.A + (size_t)cur.pm * tstepA; const char* cB = (const char*)g.Bt + (size_t)cur.pn * tstepB;
    S.a_ready(cur);
    if constexpr (SP2) {
        PG8_STAGE(PG8_SB(0, 0), cB, voffB); PG8_STAGE(PG8_SB(0, 1), cB + hstepB, voffB); PG8_STAGE(PG8_SA(0, 0), cA, voffA); PG8_STAGE(PG8_SA(0, 1), cA + hstepA, voffA);
        if (wr == 1) PG8_BAR;
        PG8_WAIT_V(2); PG8_BAR;
        PG8_STAGE(PG8_SB(1, 0), cB + kstep, voffB); PG8_STAGE(PG8_SA(1, 0), cA + kstep, voffA); PG8_STAGE(PG8_SB(1, 1), cB + hstepB + kstep, voffB);
        PG8_WAIT_V(6); PG8_BAR;
    } else {
        PG8_STAGE(PG8_SB(0, 0), cB, voffB); PG8_STAGE(PG8_SA(0, 0), cA, voffA); PG8_STAGE(PG8_SB(0, 1), cB + hstepB, voffB); PG8_STAGE(PG8_SA(0, 1), cA + hstepA, voffA);
        if (wr == 1) PG8_BAR;
        PG8_WAIT_V(4); PG8_BAR;
        PG8_STAGE(PG8_SB(1, 0), cB + kstep, voffB); PG8_STAGE(PG8_SA(1, 0), cA + kstep, voffA); PG8_STAGE(PG8_SB(1, 1), cB + hstepB + kstep, voffB);
        PG8_WAIT_V(6); PG8_BAR;
    }
    for (;;) {
        const bool has_next = S.next(ui + 1, nxt);
        const char* nA = has_next ? (const char*)g.A + (size_t)nxt.pm * tstepA : cA; const char* nB = has_next ? (const char*)g.Bt + (size_t)nxt.pn * tstepB : cB;
#pragma unroll 1
        for (int t = 0; t < nt; t += 2) {
            const bool last = (t == nt - 2);
            const char* a1 = cA + (size_t)(t + 1) * kstep;
            const char* a2 = last ? nA : cA + (size_t)(t + 2) * kstep; const char* b2 = last ? nB : cB + (size_t)(t + 2) * kstep;
            const char* a3 = a2 + kstep; const char* b3 = b2 + kstep;
            if (last && has_next) S.a_ready(nxt);
            if constexpr (SP2) {
            PG8_LDB(B0, 0, 0); PG8_LDB(B1, 0, 1); PG8_SCHED; PG8_LDA(At, 0, 0); PG8_STAGE(PG8_SA(1, 1), a1 + hstepA, voffA);
            PG8_WAIT_V(8); PG8_WAIT_L(0); PG8_BAR; PG8_MMA(0, 0, At, B0); PG8_MMA(0, 1, At, B1); PG8_BAR; PG8_SCHED;
            PG8_LDA(At, 0, 1); PG8_STAGE(PG8_SB(0, 0), b2, voffB); PG8_STAGE(PG8_SB(0, 1), b2 + hstepB, voffB); PG8_STAGE(PG8_SA(0, 0), a2, voffA);
            PG8_WAIT_V(8); PG8_WAIT_L(0); PG8_BAR; PG8_MMA(1, 0, At, B0); PG8_MMA(1, 1, At, B1); PG8_BAR; PG8_SCHED;
            PG8_LDB(B0, 1, 0); PG8_LDB(B1, 1, 1); PG8_SCHED; PG8_LDA(At, 1, 0); PG8_STAGE(PG8_SA(0, 1), a2 + hstepA, voffA);
            PG8_WAIT_V(8); PG8_WAIT_L(0); PG8_BAR; PG8_MMA(0, 0, At, B0); PG8_MMA(0, 1, At, B1); PG8_BAR; PG8_SCHED;
            PG8_LDA(At, 1, 1); PG8_STAGE(PG8_SB(1, 0), b3, voffB); PG8_STAGE(PG8_SB(1, 1), b3 + hstepB, voffB); PG8_STAGE(PG8_SA(1, 0), a3, voffA);
            PG8_WAIT_V(8); PG8_WAIT_L(0); PG8_BAR; PG8_MMA(1, 0, At, B0); PG8_MMA(1, 1, At, B1); PG8_BAR; PG8_SCHED;
            } else {
            PG8_LDB(B0, 0, 0); PG8_SCHED; PG8_LDA(At, 0, 0); PG8_STAGE(PG8_SA(1, 1), a1 + hstepA, voffA);
            PG8_WAIT_L(8); PG8_BAR; PG8_WAIT_L(0); PG8_MMA(0, 0, At, B0); PG8_BAR; PG8_SCHED;
            PG8_LDB(B1, 0, 1); PG8_STAGE(PG8_SB(0, 0), b2, voffB);
            PG8_BAR; PG8_WAIT_L(0); PG8_MMA(0, 1, At, B1); PG8_BAR;
            PG8_LDA(At, 0, 1); PG8_STAGE(PG8_SA(0, 0), a2, voffA);
            PG8_BAR; PG8_WAIT_L(0); PG8_MMA(1, 0, At, B0); PG8_BAR; PG8_SCHED;
            PG8_STAGE(PG8_SB(0, 1), b2 + hstepB, voffB);
            PG8_WAIT_V(6); PG8_BAR; PG8_MMA(1, 1, At, B1); PG8_BAR;
            PG8_LDB(B0, 1, 0); PG8_SCHED; PG8_LDA(At, 1, 0); PG8_STAGE(PG8_SA(0, 1), a2 + hstepA, voffA);
            PG8_WAIT_L(8); PG8_BAR; PG8_WAIT_L(0); PG8_MMA(0, 0, At, B0); PG8_BAR; PG8_SCHED;
            PG8_LDB(B1, 1, 1); PG8_STAGE(PG8_SB(1, 0), b3, voffB);
            PG8_BAR; PG8_WAIT_L(0); PG8_MMA(0, 1, At, B1); PG8_BAR;
            PG8_LDA(At, 1, 1); PG8_STAGE(PG8_SA(1, 0), a3, voffA);
            PG8_BAR; PG8_WAIT_L(0); PG8_MMA(1, 0, At, B0); PG8_BAR; PG8_SCHED;
            PG8_STAGE(PG8_SB(1, 1), b3 + hstepB, voffB);
            PG8_WAIT_V(6); PG8_BAR; PG8_MMA(1, 1, At, B1); PG8_BAR;
            }
        }
        if constexpr (ALIGN_EPI) { if (wr == 0) PG8_BAR; }
        E(acc, cur, wr, wc, fr, fq); S.done(cur);
        if (!has_next) break;
#pragma unroll
        for (int a = 0; a < 2; ++a)
#pragma unroll
            for (int b = 0; b < 2; ++b)
#pragma unroll
                for (int m = 0; m < 4; ++m)
#pragma unroll
                    for (int n = 0; n < 2; ++n) acc[a][b][m][n] = (f32x4){0.f, 0.f, 0.f, 0.f};
        cur = nxt; cA = nA; cB = nB; ++ui;
        if constexpr (ALIGN_EPI) { if (wr == 1) PG8_BAR; }
    }
    PG8_WAIT_V(0);
    if constexpr (!ALIGN_EPI) { if (wr == 0) PG8_BAR; }
    PG8_BAR;
#undef PG8_SA
#undef PG8_SB
#undef PG8_STAGE
#undef PG8_LDA
#undef PG8_LDB
#undef PG8_MMA
#undef PG8_WAIT_V
#undef PG8_WAIT_L
#undef PG8_BAR
#undef PG8_SCHED
}
}
using pg8::Unit;

__device__ __forceinline__ float rstd_of(const u64* st, int row) { return 1.0f / sqrtf((float)st[row] * (1.0f / (STAT_FIX * (float)D)) + EPS); }
#define EPI_ROWS_BEGIN _Pragma("unroll") for (int ai = 0; ai < 2; ++ai) _Pragma("unroll") for (int m = 0; m < 4; ++m) { const int row = u.pm * 256 + ai * 128 + wr * 64 + m * 16 + fr;
#define EPI_ROWS_END }
#define EPI_LOAD_RSTD(rsv, stp) float rsv[2][4]; { u64 sv_[2][4]; \
    _Pragma("unroll") for (int ai = 0; ai < 2; ++ai) _Pragma("unroll") for (int m = 0; m < 4; ++m) sv_[ai][m] = ((const GAS u64*)(stp))[u.pm * 256 + ai * 128 + wr * 64 + m * 16 + fr]; \
    _Pragma("unroll") for (int ai = 0; ai < 2; ++ai) _Pragma("unroll") for (int m = 0; m < 4; ++m) rsv[ai][m] = __builtin_amdgcn_rsqf((float)sv_[ai][m] * (1.0f / (STAT_FIX * (float)D)) + EPS); }

struct EpiSwiglu {
    static constexpr bool PERM = true;
    bf16_t* O; int ldc; const u64* st;
    __device__ __forceinline__ void operator()(const f32x4 (&acc)[2][2][4][2], const Unit& u, int wr, int wc, int fr, int fq) const {
        const int col = u.pn * 128 + wc * 32 + 8 * fq;
        EPI_LOAD_RSTD(rsv, st)
        EPI_ROWS_BEGIN
            const float rs = rsv[ai][m], kneg = -rs * LOG2E, cinv = __builtin_amdgcn_rcpf(rs * rs);
            f32x4 a0, a1;
#pragma unroll
            for (int e = 0; e < 4; ++e) { const float g0 = acc[ai][0][m][0][e], g1 = acc[ai][0][m][1][e];
                const float e0 = __builtin_amdgcn_exp2f(g0 * kneg), e1 = __builtin_amdgcn_exp2f(g1 * kneg);
                a0[e] = (g0 * acc[ai][1][m][0][e]) * __builtin_amdgcn_rcpf(__builtin_fmaf(e0, cinv, cinv)); a1[e] = (g1 * acc[ai][1][m][1][e]) * __builtin_amdgcn_rcpf(__builtin_fmaf(e1, cinv, cinv)); }
            *(u32x4*)(O + (size_t)row * ldc + col) = pack8f(a0, a1);
        EPI_ROWS_END
    }
};
struct EpiResid {
    static constexpr bool PERM = true;
    bf16_t* xb; float alpha; u64* st;
    __device__ __forceinline__ void operator()(const f32x4 (&acc)[2][2][4][2], const Unit& u, int wr, int wc, int fr, int fq) const {
        const bool do_st = (st != nullptr);
        u32x4 b[2][4][2];
#pragma unroll
        for (int ai = 0; ai < 2; ++ai)
#pragma unroll
            for (int m = 0; m < 4; ++m)
#pragma unroll
                for (int bj = 0; bj < 2; ++bj) { const size_t off = (size_t)(u.pm * 256 + ai * 128 + wr * 64 + m * 16 + fr) * D + u.pn * 256 + bj * 128 + wc * 32 + 8 * fq;
                    b[ai][m][bj] = *(const GAS u32x4*)((const GAS bf16_t*)xb + off); }
#pragma unroll
        for (int ai = 0; ai < 2; ++ai) {
#pragma unroll
            for (int m = 0; m < 4; ++m) { const int row = u.pm * 256 + ai * 128 + wr * 64 + m * 16 + fr; float q = 0.f;
#pragma unroll
                for (int bj = 0; bj < 2; ++bj) { const size_t off = (size_t)row * D + u.pn * 256 + bj * 128 + wc * 32 + 8 * fq;
                    const u32x4 o = b[ai][m][bj]; f32x4 x0, x1;
                    x0[0] = bf_lo(o.x) + acc[ai][bj][m][0][0] * alpha; x0[1] = bf_hi(o.x) + acc[ai][bj][m][0][1] * alpha; x0[2] = bf_lo(o.y) + acc[ai][bj][m][0][2] * alpha; x0[3] = bf_hi(o.y) + acc[ai][bj][m][0][3] * alpha;
                    x1[0] = bf_lo(o.z) + acc[ai][bj][m][1][0] * alpha; x1[1] = bf_hi(o.z) + acc[ai][bj][m][1][1] * alpha; x1[2] = bf_lo(o.w) + acc[ai][bj][m][1][2] * alpha; x1[3] = bf_hi(o.w) + acc[ai][bj][m][1][3] * alpha;
                    *(GAS u32x4*)((GAS bf16_t*)xb + off) = pack8f(x0, x1);
                    if (do_st) q += ((x0[0] * x0[0] + x0[1] * x0[1]) + (x0[2] * x0[2] + x0[3] * x0[3])) + ((x1[0] * x1[0] + x1[1] * x1[1]) + (x1[2] * x1[2] + x1[3] * x1[3])); }
                if (do_st) { q += __shfl_xor(q, 16); q += __shfl_xor(q, 32);
                    if (fq == 0) __hip_atomic_fetch_add((GAS u64*)st + row, (u64)(q * STAT_FIX), __ATOMIC_RELAXED, __HIP_MEMORY_SCOPE_AGENT); } }
            __builtin_amdgcn_sched_barrier(0);
        }
    }
};
template <int ACT> struct EpiBf16 {
    static constexpr bool PERM = true;
    bf16_t* O; int ldc; int ncols; const float* bias; const u64* st;
    __device__ __forceinline__ void operator()(const f32x4 (&acc)[2][2][4][2], const Unit& u, int wr, int wc, int fr, int fq) const {
        float rsv[2][4];
        if (st) { EPI_LOAD_RSTD(rs2, st)
#pragma unroll
            for (int ai = 0; ai < 2; ++ai)
#pragma unroll
                for (int m = 0; m < 4; ++m) rsv[ai][m] = rs2[ai][m]; }
#pragma unroll
        for (int bj = 0; bj < 2; ++bj) { const int c0 = u.pn * 256 + bj * 128 + wc * 32 + 8 * fq;
            if (c0 < ncols) {
                f32x4 bv0 = {0.f, 0.f, 0.f, 0.f}, bv1 = {0.f, 0.f, 0.f, 0.f};
                if (ACT == 2) { bv0 = *(const f32x4*)(bias + c0); bv1 = *(const f32x4*)(bias + c0 + 4); }
                EPI_ROWS_BEGIN
                    f32x4 v0 = acc[ai][bj][m][0], v1 = acc[ai][bj][m][1];
                    if (ACT == 2) { v0 = v0 + bv0; v1 = v1 + bv1; }
                    if (ACT == 1) {
                        const float kneg = st ? -rsv[ai][m] * LOG2E : -LOG2E;
#pragma unroll
                        for (int e = 0; e < 4; ++e) { v0[e] = __builtin_amdgcn_rcpf(1.0f + __builtin_amdgcn_exp2f(v0[e] * kneg)); v1[e] = __builtin_amdgcn_rcpf(1.0f + __builtin_amdgcn_exp2f(v1[e] * kneg)); } }
                    else if (st) { const float rs = rsv[ai][m]; v0 = v0 * rs; v1 = v1 * rs; }
                    if (ACT == 2) {
#pragma unroll
                        for (int e = 0; e < 4; ++e) { v0[e] = v0[e] * fast_sigmoid(v0[e]); v1[e] = v1[e] * fast_sigmoid(v1[e]); } }
                    *(u32x4*)(O + (size_t)row * ldc + c0) = pack8f(v0, v1);
                EPI_ROWS_END
            } }
    }
};
struct EpiBranch {
    static constexpr bool PERM = true;
    bf16_t* mixed; const bf16_t* G; int goff; int first;
    __device__ __forceinline__ void operator()(const f32x4 (&acc)[2][2][4][2], const Unit& u, int wr, int wc, int fr, int fq) const {
#pragma unroll
        for (int ai = 0; ai < 2; ++ai) {
            u32x4 gq[4][2], oq[4][2];
#pragma unroll
            for (int m = 0; m < 4; ++m)
#pragma unroll
                for (int bj = 0; bj < 2; ++bj) { const int row = u.pm * 256 + ai * 128 + wr * 64 + m * 16 + fr, c0 = u.pn * 256 + bj * 128 + wc * 32 + 8 * fq;
                    gq[m][bj] = *(const GAS u32x4*)((const GAS bf16_t*)G + (size_t)row * 6144 + goff + c0);
                    if (!first) oq[m][bj] = *(const GAS u32x4*)((const GAS bf16_t*)mixed + (size_t)row * 2048 + c0); }
#pragma unroll
            for (int m = 0; m < 4; ++m)
#pragma unroll
                for (int bj = 0; bj < 2; ++bj) { const int row = u.pm * 256 + ai * 128 + wr * 64 + m * 16 + fr, c0 = u.pn * 256 + bj * 128 + wc * 32 + 8 * fq;
                    const u32x4 g4 = gq[m][bj]; f32x4 v0, v1;
                    v0[0] = bf_lo(g4.x) * acc[ai][bj][m][0][0]; v0[1] = bf_hi(g4.x) * acc[ai][bj][m][0][1]; v0[2] = bf_lo(g4.y) * acc[ai][bj][m][0][2]; v0[3] = bf_hi(g4.y) * acc[ai][bj][m][0][3];
                    v1[0] = bf_lo(g4.z) * acc[ai][bj][m][1][0]; v1[1] = bf_hi(g4.z) * acc[ai][bj][m][1][1]; v1[2] = bf_lo(g4.w) * acc[ai][bj][m][1][2]; v1[3] = bf_hi(g4.w) * acc[ai][bj][m][1][3];
                    if (!first) { const u32x4 o = oq[m][bj];
                        v0[0] += bf_lo(o.x); v0[1] += bf_hi(o.x); v0[2] += bf_lo(o.y); v0[3] += bf_hi(o.y); v1[0] += bf_lo(o.z); v1[1] += bf_hi(o.z); v1[2] += bf_lo(o.w); v1[3] += bf_hi(o.w); }
                    *(GAS u32x4*)((GAS bf16_t*)mixed + (size_t)row * 2048 + c0) = pack8f(v0, v1); }
            asm volatile("" ::: "memory");
        }
    }
};
__device__ __forceinline__ void rope8(f32x4& v0, f32x4& v1, const f32x4 cs0, const f32x4 cs1) {
    const float a0 = v0[0] * cs0[0] - v0[1] * cs0[1], b0 = v0[0] * cs0[1] + v0[1] * cs0[0];
    const float a1 = v0[2] * cs0[2] - v0[3] * cs0[3], b1 = v0[2] * cs0[3] + v0[3] * cs0[2];
    const float a2 = v1[0] * cs1[0] - v1[1] * cs1[1], b2 = v1[0] * cs1[1] + v1[1] * cs1[0];
    const float a3 = v1[2] * cs1[2] - v1[3] * cs1[3], b3 = v1[2] * cs1[3] + v1[3] * cs1[2];
    v0 = (f32x4){a0, b0, a1, b1}; v1 = (f32x4){a2, b2, a3, b3};
}
struct EpiProj {
    static constexpr bool PERM = true;
    unsigned char* ws; const float* tab; const u64* st;
    __device__ __forceinline__ void operator()(const f32x4 (&acc)[2][2][4][2], const Unit& u, int wr, int wc, int fr, int fq) const {
        EPI_LOAD_RSTD(rsv, st)
#pragma unroll
        for (int bj = 0; bj < 2; ++bj) { const int c0 = u.pn * 256 + bj * 128 + wc * 32 + 8 * fq;
            int kind = 1, ld = 0, tabo = 0; float scale = 1.f; bf16_t* dst = nullptr;
            if (c0 < 768) { dst = (bf16_t*)(ws + B_CQ) + c0; ld = 768; }
            else if (c0 < 1280) { dst = (bf16_t*)(ws + B_CKV) + (c0 - 768); ld = 512; }
            else if (c0 < 1344) { const int p = c0 - 1280; kind = 4; tabo = p >> 1; dst = (bf16_t*)(ws + B_KM) + 128 + p; ld = 1152; }
            else if (c0 < 2112) { const int p = c0 - 1344, w = p % 192; kind = 2; tabo = 32 + (w >> 1); scale = QS192; dst = (bf16_t*)(ws + B_NQ) + p; ld = 768; }
            else if (c0 < 2304) { const int p = c0 - 2112; kind = 2; tabo = 32 + (p >> 1); dst = (bf16_t*)(ws + B_KCMP) + p; ld = 192; }
            else if (c0 < 2432) { dst = (bf16_t*)(ws + B_VCMP) + (c0 - 2304); ld = 128; }
            else if (c0 < 2624) { const int p = c0 - 2432; kind = 2; tabo = 32 + (p >> 1); dst = (bf16_t*)(ws + B_KSLC) + p; ld = 192; }
            else if (c0 < 2752) { dst = (bf16_t*)(ws + B_VSLC) + (c0 - 2624); ld = 128; }
            else if (c0 < 2944) { const int p = c0 - 2752; kind = 2; tabo = 32 + (p >> 1); dst = (bf16_t*)(ws + B_KWIN) + p; ld = 192; }
            else if (c0 < 3072) { dst = (bf16_t*)(ws + B_VWIN) + (c0 - 2944); ld = 128; }
            else if (c0 < 3088) { kind = 3; }
            else if (c0 < 3856) { const int p = c0 - 3088, w = p % 96; kind = 2; tabo = 128 + (w >> 1); scale = QS96; dst = (bf16_t*)(ws + B_DQ) + p; ld = 768; }
            else if (c0 < 4624) { const int p = c0 - 3856, w = p % 96; kind = 2; tabo = 128 + (w >> 1); dst = (bf16_t*)(ws + B_DK) + p; ld = 768; }
            else if (c0 < 5392) { dst = (bf16_t*)(ws + B_DV) + (c0 - 4624); ld = 768; }
            else kind = 0;
            if (kind == 0) continue;
#pragma unroll
            for (int ai = 0; ai < 2; ++ai) {
                f32x4 cs0[4], cs1[4];
                if (kind == 2 || kind == 4) {
#pragma unroll
                    for (int m = 0; m < 4; ++m) { const int row = u.pm * 256 + ai * 128 + wr * 64 + m * 16 + fr; const GAS float* tp = (const GAS float*)tab + ((size_t)(row & (SEQ - 1)) * NTAB + tabo) * 2;
                        cs0[m] = *(const GAS f32x4*)tp; cs1[m] = *(const GAS f32x4*)(tp + 4); }
                }
#pragma unroll
                for (int m = 0; m < 4; ++m) { const int row = u.pm * 256 + ai * 128 + wr * 64 + m * 16 + fr;
                const float rs = rsv[ai][m];
                f32x4 v0 = acc[ai][bj][m][0] * rs, v1 = acc[ai][bj][m][1] * rs;
                if (kind == 3) {
                    float* gp = (float*)(ws + B_NGATE) + (size_t)row * 16 + (c0 - 3072);
#pragma unroll
                    for (int e = 0; e < 4; ++e) { v0[e] = fast_sigmoid(v0[e]); v1[e] = fast_sigmoid(v1[e]); }
                    *(f32x4*)gp = v0; *(f32x4*)(gp + 4) = v1;
                } else {
                    if (kind == 2 || kind == 4) rope8(v0, v1, cs0[m], cs1[m]);
                    v0 = v0 * scale; v1 = v1 * scale;
                    const u32x4 w = pack8f(v0, v1);
                    bf16_t* p = dst + (size_t)row * ld;
                    *(u32x4*)p = w;
                    if (kind == 4) {
#pragma unroll
                        for (int hh = 1; hh < 6; ++hh) *(u32x4*)(p + hh * 192) = w; }
                }
                }
            }
        }
    }
};
struct EpiUq {
    static constexpr bool PERM = true;
    bf16_t* QM; const float* tab;
    __device__ __forceinline__ void operator()(const f32x4 (&acc)[2][2][4][2], const Unit& u, int wr, int wc, int fr, int fq) const {
#pragma unroll
        for (int bj = 0; bj < 2; ++bj) { const int c0 = u.pn * 256 + bj * 128 + wc * 32 + 8 * fq;
            if (c0 >= 1152) continue;
            const int w = c0 % 192; const bool rp = w >= 128; const int tabo = rp ? ((w - 128) >> 1) : 0;
#pragma unroll
            for (int ai = 0; ai < 2; ++ai) {
                f32x4 cs0[4], cs1[4];
                if (rp) {
#pragma unroll
                    for (int m = 0; m < 4; ++m) { const int row = u.pm * 256 + ai * 128 + wr * 64 + m * 16 + fr; const GAS float* tp = (const GAS float*)tab + ((size_t)(row & (SEQ - 1)) * NTAB + tabo) * 2;
                        cs0[m] = *(const GAS f32x4*)tp; cs1[m] = *(const GAS f32x4*)(tp + 4); }
                }
#pragma unroll
                for (int m = 0; m < 4; ++m) { const int row = u.pm * 256 + ai * 128 + wr * 64 + m * 16 + fr;
                    f32x4 v0 = acc[ai][bj][m][0], v1 = acc[ai][bj][m][1];
                    if (rp) rope8(v0, v1, cs0[m], cs1[m]);
                    v0 = v0 * QS192; v1 = v1 * QS192;
                    *(u32x4*)(QM + (size_t)row * 1152 + c0) = pack8f(v0, v1); }
            }
        }
    }
};
struct EpiUkv {
    static constexpr bool PERM = true;
    bf16_t* KM; bf16_t* VM;
    __device__ __forceinline__ void operator()(const f32x4 (&acc)[2][2][4][2], const Unit& u, int wr, int wc, int fr, int fq) const {
#pragma unroll
        for (int bj = 0; bj < 2; ++bj) { const int c0 = u.pn * 256 + bj * 128 + wc * 32 + 8 * fq;
            const int hh = c0 >> 8, w = c0 & 255;
            bf16_t* dst = (w < 128) ? (KM + hh * 192 + w) : (VM + hh * 128 + (w - 128)); const int ld = (w < 128) ? 1152 : 768;
            EPI_ROWS_BEGIN *(u32x4*)(dst + (size_t)row * ld) = pack8f(acc[ai][bj][m][0], acc[ai][bj][m][1]); EPI_ROWS_END
        }
    }
};

enum { MAP_ID = 0, MAP_PADN, MAP_FFN_IN, MAP_GATE, MAP_UQ, MAP_ROPE192, MAP_PROJ };
__device__ __forceinline__ int map_src(int kind, int n, int nvalid) {
    if (kind == MAP_ID) return n;
    if (kind == MAP_PADN) return n < nvalid ? n : -1;
    if (kind == MAP_FFN_IN) { const int pn = n >> 8, tc = n & 255; return (tc < 128) ? (pn * 128 + tc) : (DFF + pn * 128 + (tc - 128)); }
    if (kind == MAP_GATE) return 5388 + n;
    if (kind == MAP_ROPE192) return n < 192 ? (n >> 1) + 96 * (n & 1) : -1;
    if (kind == MAP_UQ) { if (n >= 1152) return -1; const int hh = n / 192, w = n % 192; if (w < 128) return n; const int p = w - 128; return hh * 192 + 128 + (p >> 1) + 32 * (p & 1); }
    if (n < 1280) return n;
    if (n < 1344) { const int p = n - 1280; return 1280 + (p >> 1) + 32 * (p & 1); }
    if (n < 2112) { const int p = n - 1344, hh = p / 192, w = p % 192; return 1344 + hh * 192 + (w >> 1) + 96 * (w & 1); }
    if (n < 2304) { const int p = n - 2112; return 2112 + (p >> 1) + 96 * (p & 1); }
    if (n < 2432) return n;
    if (n < 2624) { const int p = n - 2432; return 2432 + (p >> 1) + 96 * (p & 1); }
    if (n < 2752) return n;
    if (n < 2944) { const int p = n - 2752; return 2752 + (p >> 1) + 96 * (p & 1); }
    if (n < 3072) return n;
    if (n < 3088) { const int p = n - 3072; return p < 12 ? 3072 + p : -1; }
    if (n < 3856) { const int p = n - 3088, hs = p / 96, w = p % 96; return 3084 + hs * 96 + (w >> 1) + 48 * (w & 1); }
    if (n < 4624) { const int p = n - 3856, hs = p / 96, w = p % 96; return 3852 + hs * 96 + (w >> 1) + 48 * (w & 1); }
    if (n < 5392) return 4620 + (n - 4624);
    return -1;
}
__device__ __forceinline__ void conv_job(const float* W, int K, int ldw, int kind, int nvalid, bf16_t* WT, int ndst, LAS float* scr, int gw, int ngw, int lane, bool krope192 = false, const float* kscale = nullptr) {
    const int nblk = ndst / 32, nitems = (K / 64) * nblk;
    for (int item = gw; item < nitems; item += ngw) {
        const int kb = item / nblk, nb = item % nblk, k0 = 64 * kb, n0 = 32 * nb;
        const int sc = map_src(kind, n0 + (lane & 31), nvalid);
        const GAS float* src = (const GAS float*)W + (sc < 0 ? 0 : sc);
        float vals[32];
#pragma unroll
        for (int i = 0; i < 32; ++i) { int kr = k0 + 2 * i + (lane >> 5);
            if (krope192) { const int l_ = kr / 192, dp = kr % 192; kr = l_ * 192 + (dp >> 1) + 96 * (dp & 1); }
            vals[i] = src[(size_t)kr * ldw]; }
        const float gsc = kscale ? ((const GAS float*)kscale)[k0 + lane] : 1.0f;
#pragma unroll
        for (int i = 0; i < 32; ++i) scr[(2 * i + (lane >> 5)) * 33 + (lane & 31)] = (sc >= 0) ? vals[i] : 0.f;
        scr[64 * 33 + lane] = gsc;
        asm volatile("s_waitcnt lgkmcnt(0)" ::: "memory");
        const int c = lane & 7;
        float gk[8];
#pragma unroll
        for (int kk = 0; kk < 8; ++kk) gk[kk] = scr[64 * 33 + 8 * c + kk];
#pragma unroll
        for (int j = 0; j < 4; ++j) { const int n = (lane >> 3) + 8 * j; const LAS float* s = scr + (8 * c) * 33 + n;
            u32x4 o; o.x = cvt_pk_bf16(s[0 * 33] * gk[0], s[1 * 33] * gk[1]); o.y = cvt_pk_bf16(s[2 * 33] * gk[2], s[3 * 33] * gk[3]); o.z = cvt_pk_bf16(s[4 * 33] * gk[4], s[5 * 33] * gk[5]); o.w = cvt_pk_bf16(s[6 * 33] * gk[6], s[7 * 33] * gk[7]);
            *(GAS u32x4*)((GAS bf16_t*)WT + (size_t)(n0 + n) * K + k0 + 8 * c) = o; }
        asm volatile("s_waitcnt lgkmcnt(0)" ::: "memory");
    }
}
__device__ __forceinline__ void rms_row_bf16(const float* xrow, const float* w, bf16_t* orow, int lane) {
    const GAS f32x4* xr = (const GAS f32x4*)xrow + lane; const GAS f32x4* wr_ = (const GAS f32x4*)w + lane;
    f32x4 v[8]; float s = 0.f;
#pragma unroll
    for (int j = 0; j < 8; ++j) { v[j] = xr[64 * j]; s += (v[j][0] * v[j][0] + v[j][1] * v[j][1]) + (v[j][2] * v[j][2] + v[j][3] * v[j][3]); }
    const float rstd = 1.0f / sqrtf(wave_sum(s) * (1.0f / D) + EPS);
    GAS u32x2* o8 = (GAS u32x2*)orow + lane;
#pragma unroll
    for (int j = 0; j < 8; ++j) { const f32x4 g = wr_[64 * j]; u32x2 o; o.x = cvt_pk_bf16(v[j][0] * rstd * g[0], v[j][1] * rstd * g[1]); o.y = cvt_pk_bf16(v[j][2] * rstd * g[2], v[j][3] * rstd * g[3]); o8[64 * j] = o; }
}
__device__ __forceinline__ void xb_row_stats(const float* xrow, bf16_t* orow, u64* st, int lane) {
    const GAS f32x4* xr = (const GAS f32x4*)xrow + lane;
    f32x4 v[8]; float s = 0.f;
#pragma unroll
    for (int j = 0; j < 8; ++j) { v[j] = xr[64 * j]; s += (v[j][0] * v[j][0] + v[j][1] * v[j][1]) + (v[j][2] * v[j][2] + v[j][3] * v[j][3]); }
    s = wave_sum(s);
    GAS u32x2* o8 = (GAS u32x2*)orow + lane;
#pragma unroll
    for (int j = 0; j < 8; ++j) { u32x2 o; o.x = cvt_pk_bf16(v[j][0], v[j][1]); o.y = cvt_pk_bf16(v[j][2], v[j][3]); o8[64 * j] = o; }
    if (lane == 0) *st = (u64)(s * STAT_FIX);
}
__device__ __forceinline__ void rms_row_out(const bf16_t* xrow, float* orow, const float* w, int lane) {
    const GAS u32x4* xr = (const GAS u32x4*)xrow + lane;
    u32x4 v[4]; float s = 0.f;
#pragma unroll
    for (int j = 0; j < 4; ++j) { v[j] = xr[64 * j];
        s += ((bf_lo(v[j].x) * bf_lo(v[j].x) + bf_hi(v[j].x) * bf_hi(v[j].x)) + (bf_lo(v[j].y) * bf_lo(v[j].y) + bf_hi(v[j].y) * bf_hi(v[j].y)))
           + ((bf_lo(v[j].z) * bf_lo(v[j].z) + bf_hi(v[j].z) * bf_hi(v[j].z)) + (bf_lo(v[j].w) * bf_lo(v[j].w) + bf_hi(v[j].w) * bf_hi(v[j].w))); }
    const float rstd = 1.0f / sqrtf(wave_sum(s) * (1.0f / D) + EPS);
#pragma unroll
    for (int j = 0; j < 4; ++j) { const int c = 8 * (lane + 64 * j); const f32x4 g0 = *(const f32x4*)(w + c), g1 = *(const f32x4*)(w + c + 4);
        const f32x4 y0 = {bf_lo(v[j].x) * rstd * g0[0], bf_hi(v[j].x) * rstd * g0[1], bf_lo(v[j].y) * rstd * g0[2], bf_hi(v[j].y) * rstd * g0[3]};
        const f32x4 y1 = {bf_lo(v[j].z) * rstd * g1[0], bf_hi(v[j].z) * rstd * g1[1], bf_lo(v[j].w) * rstd * g1[2], bf_hi(v[j].w) * rstd * g1[3]};
        *(GAS f32x4*)((GAS float*)orow + c) = y0; *(GAS f32x4*)((GAS float*)orow + c + 4) = y1; }
}
template <int NC> __device__ __forceinline__ void rms_row_inplace_bf16(bf16_t* row, const float* w, int lane) {
    u32x2* p = (u32x2*)row + lane; float v[NC / 256][4]; float s = 0.f;
#pragma unroll
    for (int j = 0; j < NC / 256; ++j) { const u32x2 q = p[64 * j]; v[j][0] = bf_lo(q.x); v[j][1] = bf_hi(q.x); v[j][2] = bf_lo(q.y); v[j][3] = bf_hi(q.y);
        s += (v[j][0] * v[j][0] + v[j][1] * v[j][1]) + (v[j][2] * v[j][2] + v[j][3] * v[j][3]); }
    const float rstd = 1.0f / sqrtf(wave_sum(s) * (1.0f / NC) + EPS);
#pragma unroll
    for (int j = 0; j < NC / 256; ++j) { const f32x4 g = *((const f32x4*)w + lane + 64 * j); u32x2 o; o.x = cvt_pk_bf16(v[j][0] * rstd * g[0], v[j][1] * rstd * g[1]); o.y = cvt_pk_bf16(v[j][2] * rstd * g[2], v[j][3] * rstd * g[3]); p[64 * j] = o; }
}
__device__ __forceinline__ void rope_entry(int pos, int fi, float& c, float& s) {
    double r; int i;
    if (fi < 32) { r = 0.7498942093324558273; i = fi; } else if (fi < 128) { r = 0.9085175756516867878; i = fi - 32; } else { r = 0.8254041852680184257; i = fi - 128; }
    double inv = 1.0, b = r; int e = i;
#pragma unroll
    for (int k = 0; k < 7; ++k) { if (e & 1) inv *= b; b *= b; e >>= 1; }
    const float ang = (float)pos * (float)inv;
    const double x = (double)ang;
    const double n = __builtin_rint(x * 0.6366197723675814);
    double y = __builtin_fma(-n, 1.5707963267948966, x); y = __builtin_fma(-n, 6.123233995736766e-17, y);
    const double y2 = y * y;
    double sp = 1.0 / 362880.0; sp = sp * y2 - 1.0 / 5040.0; sp = sp * y2 + 1.0 / 120.0; sp = sp * y2 - 1.0 / 6.0; sp = sp * y2 + 1.0; sp *= y;
    double cp = -1.0 / 3628800.0; cp = cp * y2 + 1.0 / 40320.0; cp = cp * y2 - 1.0 / 720.0; cp = cp * y2 + 1.0 / 24.0; cp = cp * y2 - 0.5; cp = cp * y2 + 1.0;
    const int q = ((int)n) & 3;
    const double sn = (q == 0) ? sp : (q == 1) ? cp : (q == 2) ? -sp : -cp;
    const double cn = (q == 0) ? cp : (q == 1) ? -sp : (q == 2) ? -cp : sp;
    c = (float)cn; s = (float)sn;
}

template <int DK, int DV> struct AT {
    static constexpr int KROW = DK * 2 + 16, VROW = DV * 2 + 64, KBUF = 64 * KROW, VBUF = 64 * VROW;
    static constexpr int KCPR = DK / 8, VCPR = DV / 8, KCH = 64 * KCPR, VCH = 64 * VCPR, KN = (KCH + 511) / 512, VN = (VCH + 511) / 512;
    static constexpr int NS = DK / 16, NDB = DV / 32;
};
struct AttnSrc { const bf16_t* K; const bf16_t* V; int ks, vs; };
constexpr float ATT_THR = 6.0f;
constexpr float NEG_INF_F = -__builtin_inff();

__device__ __forceinline__ bf16x8 pack_p(const f32x16& p, int b) {
    u32x4 w; w.x = cvt_pk_bf16(p[b + 0], p[b + 1]); w.y = cvt_pk_bf16(p[b + 2], p[b + 3]); w.z = cvt_pk_bf16(p[b + 4], p[b + 5]); w.w = cvt_pk_bf16(p[b + 6], p[b + 7]);
    return *reinterpret_cast<bf16x8*>(&w);
}
template <int DK, int DV, int MODE>
__device__ __forceinline__ void attn_core(LAS unsigned char* lds, const AttnSrc src, const int j_lo, const int j_hi, const bf16x8 (&qf)[DK / 16],
                                          const int qhi, const unsigned W, const int qmin_w, const int qmax_w, float& m_run, float& l_run, f32x16 (&O)[DV / 32],
                                          const LAS unsigned* selrow, const LAS unsigned* selwave, const float inv_l, LAS float* strip, LAS float* impsel_w) {
    using A = AT<DK, DV>;
    const int tid = opaque_tid(), lane = tid & 63, r = lane & 31, h = lane >> 5;
    const int nt = j_hi - j_lo;
    if (nt <= 0) return;
    LAS unsigned char* Kb = lds; LAS unsigned char* Vb = lds + 2 * A::KBUF;
    unsigned koff[A::KN], klds[A::KN], voff[A::VN], vlds[A::VN];
#pragma unroll
    for (int i = 0; i < A::KN; ++i) { const int id = tid + 512 * i, row = id / A::KCPR, c = id % A::KCPR; koff[i] = (unsigned)(row * src.ks + c * 8); klds[i] = (unsigned)(row * A::KROW + c * 16); }
#pragma unroll
    for (int i = 0; i < A::VN; ++i) { const int id = tid + 512 * i, row = id / A::VCPR, c = id % A::VCPR; voff[i] = (unsigned)(row * src.vs + c * 8); vlds[i] = (unsigned)(row * A::VROW + c * 16); }
    const bool klast = (tid + 512 * (A::KN - 1)) < A::KCH, vlast = (tid + 512 * (A::VN - 1)) < A::VCH;
    bf16x8 sk[A::KN], sv[A::VN];
    constexpr bool KFULL = (A::KCH % 512) == 0, VFULL = (A::VCH % 512) == 0;
#define AT_ISSUE(t_) do { const GAS bf16_t* kp_ = (const GAS bf16_t*)src.K + (size_t)(t_) * 64 * src.ks; \
        _Pragma("unroll") for (int i = 0; i < A::KN; ++i) if (i < A::KN - 1 || KFULL || klast) sk[i] = *(const GAS bf16x8*)(kp_ + koff[i]); \
        if (MODE != 2) { const GAS bf16_t* vp_ = (const GAS bf16_t*)src.V + (size_t)(t_) * 64 * src.vs; \
        _Pragma("unroll") for (int i = 0; i < A::VN; ++i) if (i < A::VN - 1 || VFULL || vlast) sv[i] = *(const GAS bf16x8*)(vp_ + voff[i]); } } while (0)
#define AT_WRITE(b_) do { \
        _Pragma("unroll") for (int i = 0; i < A::KN; ++i) if (i < A::KN - 1 || KFULL || klast) *(LAS bf16x8*)(Kb + (b_) * A::KBUF + klds[i]) = sk[i]; \
        if (MODE != 2) { _Pragma("unroll") for (int i = 0; i < A::VN; ++i) if (i < A::VN - 1 || VFULL || vlast) *(LAS bf16x8*)(Vb + (b_) * A::VBUF + vlds[i]) = sv[i]; } } while (0)
    __syncthreads();
    AT_ISSUE(j_lo); AT_WRITE(0);
    __syncthreads();
    const int g4 = lane >> 4, q4 = (lane >> 2) & 3, p4 = lane & 3;
    const int vlane = (4 * (g4 >> 1) + q4) * A::VROW + (16 * (g4 & 1) + 4 * p4) * 2;
    for (int it = 0; it < nt; ++it) {
        const int t = j_lo + it, cur = it & 1; bool wrote = false;
        if (it + 1 < nt) AT_ISSUE(t + 1);
        const int kbase = 64 * t;
        bool active_v = (kbase <= qmax_w) && ((long long)kbase + 63 > (long long)qmin_w - (long long)W);
        if (MODE == 1) { const unsigned uw = selwave[t >> 5]; active_v = active_v && ((uw >> (t & 31)) & 1u); }
        const bool active = __builtin_amdgcn_readfirstlane((int)active_v) != 0;
        if (active) {
            f32x16 p0, p1;
            const float base = (MODE != 2 && m_run > -1e29f) ? m_run : 0.f;
#pragma unroll
            for (int i = 0; i < 16; ++i) { p0[i] = -base; p1[i] = -base; }
            const LAS unsigned char* kb = Kb + cur * A::KBUF + r * A::KROW + h * 16;
            {
                bf16x8 fa[A::NS], fb[A::NS];
#pragma unroll
                for (int s = 0; s < 2; ++s) { fa[s] = *(const LAS bf16x8*)(kb + s * 32); fb[s] = *(const LAS bf16x8*)(kb + 32 * A::KROW + s * 32); }
#pragma unroll
                for (int s = 0; s < A::NS; ++s) {
                    if (s + 2 < A::NS) { fa[s + 2] = *(const LAS bf16x8*)(kb + (s + 2) * 32); fb[s + 2] = *(const LAS bf16x8*)(kb + 32 * A::KROW + (s + 2) * 32); }
                    p0 = __builtin_amdgcn_mfma_f32_32x32x16_bf16(fa[s], qf[s], p0, 0, 0, 0);
                    p1 = __builtin_amdgcn_mfma_f32_32x32x16_bf16(fb[s], qf[s], p1, 0, 0, 0);
                }
                __builtin_amdgcn_sched_group_barrier(0x100, 4, 0);
#pragma unroll
                for (int s = 0; s < A::NS; ++s) { __builtin_amdgcn_sched_group_barrier(0x008, 2, 0); if (s + 2 < A::NS) __builtin_amdgcn_sched_group_barrier(0x100, 2, 0); }
            }
            bool row_on = true;
            if (MODE == 1) { const unsigned rw = selrow[t >> 5]; row_on = (rw >> (t & 31)) & 1u; }
            bool need_mask = !((qmin_w >= kbase + 63) && ((long long)qmax_w - (long long)W < (long long)kbase));
            if (MODE == 1) need_mask = need_mask || !__all(row_on);
            if (need_mask) {
                const int dq = qhi - kbase - 4 * h;
#pragma unroll
                for (int i = 0; i < 16; ++i) { const int c = (i & 3) + 8 * (i >> 2);
                    if (!(row_on && (unsigned)(dq - c) < W)) p0[i] = NEG_INF_F;
                    if (!(row_on && (unsigned)(dq - c - 32) < W)) p1[i] = NEG_INF_F; }
            }
            if (MODE != 2) {
                float tmax = p0[0];
#pragma unroll
                for (int i = 1; i < 16; ++i) tmax = fmaxf(tmax, p0[i]);
#pragma unroll
                for (int i = 0; i < 16; ++i) tmax = fmaxf(tmax, p1[i]);
                { const auto rr_ = __builtin_amdgcn_permlane32_swap(__float_as_uint(tmax), __float_as_uint(tmax), false, false); tmax = fmaxf(__uint_as_float(rr_[0]), __uint_as_float(rr_[1])); }
                if (!__all(tmax + (base - m_run) <= ATT_THR)) {
                    const float mn = fmaxf(m_run, tmax + base); const float alpha = __builtin_amdgcn_exp2f(m_run - mn); const float dsh = mn - base; m_run = mn; l_run *= alpha;
#pragma unroll
                    for (int i = 0; i < 16; ++i) { p0[i] -= dsh; p1[i] -= dsh; }
#pragma unroll
                    for (int db = 0; db < A::NDB; ++db)
#pragma unroll
                        for (int i = 0; i < 16; ++i) O[db][i] *= alpha;
                }
#pragma unroll
                for (int i = 0; i < 16; ++i) { p0[i] = __builtin_amdgcn_exp2f(p0[i]); p1[i] = __builtin_amdgcn_exp2f(p1[i]); }
                bf16x8 pb[2][2];
                pb[0][0] = pack_p(p0, 0); pb[0][1] = pack_p(p0, 8); pb[1][0] = pack_p(p1, 0); pb[1][1] = pack_p(p1, 8);
                {
                    float ra = p0[0], rb = p1[15];
#pragma unroll
                    for (int i = 1; i < 16; ++i) { ra += p0[i]; rb += p1[15 - i]; }
                    float rs = ra + rb;
                    { const auto rr_ = __builtin_amdgcn_permlane32_swap(__float_as_uint(rs), __float_as_uint(rs), false, false); rs = __uint_as_float(rr_[0]) + __uint_as_float(rr_[1]); } l_run += rs; }
                const LAS unsigned char* vb = Vb + cur * A::VBUF + vlane;
                {
                    constexpr int NSTEP = A::NDB * 4;
                    s16x4 vlo[NSTEP], vhi[NSTEP];
#define AT_VOFF(k_) ((32 * (((k_) >> 1) & 1) + 16 * ((k_) & 1)) * A::VROW + 64 * ((k_) >> 2))
#pragma unroll
                    for (int k = 0; k < 2; ++k) { vlo[k] = __builtin_amdgcn_ds_read_tr16_b64_v4i16((LAS s16x4*)(vb + AT_VOFF(k))); vhi[k] = __builtin_amdgcn_ds_read_tr16_b64_v4i16((LAS s16x4*)(vb + AT_VOFF(k) + 8 * A::VROW)); }
#pragma unroll
                    for (int k = 0; k < NSTEP; ++k) {
                        if (k + 2 < NSTEP) { vlo[k + 2] = __builtin_amdgcn_ds_read_tr16_b64_v4i16((LAS s16x4*)(vb + AT_VOFF(k + 2))); vhi[k + 2] = __builtin_amdgcn_ds_read_tr16_b64_v4i16((LAS s16x4*)(vb + AT_VOFF(k + 2) + 8 * A::VROW)); }
                        const bf16x8 av = {vlo[k][0], vlo[k][1], vlo[k][2], vlo[k][3], vhi[k][0], vhi[k][1], vhi[k][2], vhi[k][3]};
                        O[k >> 2] = __builtin_amdgcn_mfma_f32_32x32x16_bf16(av, pb[(k >> 1) & 1][k & 1], O[k >> 2], 0, 0, 0);
                    }
                    __builtin_amdgcn_sched_group_barrier(0x100, 4, 1);
#pragma unroll
                    for (int k = 0; k < NSTEP; ++k) { __builtin_amdgcn_sched_group_barrier(0x008, 1, 1); if (k + 2 < NSTEP) __builtin_amdgcn_sched_group_barrier(0x100, 2, 1); }
#undef AT_VOFF
                }
            } else {
#pragma unroll
                for (int i = 0; i < 16; ++i) {
                    float a = __builtin_amdgcn_exp2f(p0[i] - m_run) * inv_l, b = __builtin_amdgcn_exp2f(p1[i] - m_run) * inv_l;
                    a += __shfl_xor(a, 8); b += __shfl_xor(b, 8); a += __shfl_xor(a, 16); b += __shfl_xor(b, 16);
                    p0[i] = a; p1[i] = b;
                }
                if (r < 8) {
                    LAS float* sp = strip + r * 68 + 4 + 4 * h;
#pragma unroll
                    for (int i4 = 0; i4 < 4; ++i4) {
                        *(LAS f32x4*)(sp + 8 * i4) = (f32x4){p0[4 * i4], p0[4 * i4 + 1], p0[4 * i4 + 2], p0[4 * i4 + 3]};
                        *(LAS f32x4*)(sp + 32 + 8 * i4) = (f32x4){p1[4 * i4], p1[4 * i4 + 1], p1[4 * i4 + 2], p1[4 * i4 + 3]};
                    }
                }
                asm volatile("s_waitcnt lgkmcnt(0)" ::: "memory");
                {
                    const int q = lane >> 3, jp = lane & 7;
                    const LAS float* sp = strip + q * 68 + 8 * jp + 3;
                    float f[9];
#pragma unroll
                    for (int k = 0; k < 9; ++k) f[k] = sp[k];
                    const float s0 = f[0] + 2.f * (f[1] + f[2] + f[3]) + f[4], s1 = f[4] + 2.f * (f[5] + f[6] + f[7]) + f[8];
                    LAS float* ip = impsel_w + q * 256 + 16 * t + 2 * jp;
                    ip[0] = s0; ip[1] = s1;
                    asm volatile("s_waitcnt lgkmcnt(0)" ::: "memory");
                    if (jp == 7) strip[q * 68 + 3] = f[8];
                }
                asm volatile("s_waitcnt lgkmcnt(0)" ::: "memory");
            }
        } else if (MODE == 2) {
            const int q = lane >> 3, jp = lane & 7;
            LAS float* ip = impsel_w + q * 256 + 16 * t + 2 * jp; ip[0] = 0.f; ip[1] = 0.f;
            if (jp == 7) strip[q * 68 + 3] = 0.f;
        }
        if (it + 1 < nt && !wrote) AT_WRITE(cur ^ 1);
        __syncthreads();
    }
#undef AT_ISSUE
#undef AT_WRITE
}

template <int NDB> __device__ __forceinline__ void store_row(bf16_t* orow, const f32x16 (&O)[NDB], float scale, int h) {
#pragma unroll
    for (int db = 0; db < NDB; ++db)
#pragma unroll
        for (int i4 = 0; i4 < 4; ++i4) { u32x2 w; w.x = cvt_pk_bf16(O[db][4 * i4] * scale, O[db][4 * i4 + 1] * scale); w.y = cvt_pk_bf16(O[db][4 * i4 + 2] * scale, O[db][4 * i4 + 3] * scale);
            *(u32x2*)(orow + 32 * db + 8 * i4 + 4 * h) = w; }
}
template <int NDB> __device__ __forceinline__ void accum_row(bf16_t* orow, const f32x16 (&O)[NDB], float scale, int h) {
#pragma unroll
    for (int db = 0; db < NDB; ++db)
#pragma unroll
        for (int i4 = 0; i4 < 4; ++i4) { u32x2* p = (u32x2*)(orow + 32 * db + 8 * i4 + 4 * h); const u32x2 o = *p; u32x2 w;
            w.x = cvt_pk_bf16(bf_lo(o.x) + O[db][4 * i4] * scale, bf_hi(o.x) + O[db][4 * i4 + 1] * scale);
            w.y = cvt_pk_bf16(bf_lo(o.y) + O[db][4 * i4 + 2] * scale, bf_hi(o.y) + O[db][4 * i4 + 3] * scale); *p = w; }
}
template <int NDB> __device__ __forceinline__ void zero_o(f32x16 (&O)[NDB]) {
#pragma unroll
    for (int db = 0; db < NDB; ++db)
#pragma unroll
        for (int i = 0; i < 16; ++i) O[db][i] = 0.f;
}

__device__ __forceinline__ float xchg_max16(float x) { const auto r_ = __builtin_amdgcn_permlane16_swap(__float_as_uint(x), __float_as_uint(x), false, false); return fmaxf(__uint_as_float(r_[0]), __uint_as_float(r_[1])); }
__device__ __forceinline__ float xchg_max32(float x) { const auto r_ = __builtin_amdgcn_permlane32_swap(__float_as_uint(x), __float_as_uint(x), false, false); return fmaxf(__uint_as_float(r_[0]), __uint_as_float(r_[1])); }
__device__ __forceinline__ float xchg_add16(float x) { const auto r_ = __builtin_amdgcn_permlane16_swap(__float_as_uint(x), __float_as_uint(x), false, false); return __uint_as_float(r_[0]) + __uint_as_float(r_[1]); }
__device__ __forceinline__ float xchg_add32(float x) { const auto r_ = __builtin_amdgcn_permlane32_swap(__float_as_uint(x), __float_as_uint(x), false, false); return __uint_as_float(r_[0]) + __uint_as_float(r_[1]); }
template <int DK, int DV, int RB>
__device__ __forceinline__ void sel16_rb(const LAS unsigned char* kE, const LAS unsigned char* kO, const LAS unsigned char* vb, const bf16x8 (&qf)[2][DK / 32], const int qhi, const int kbase, const bool diag,
                                         const bool on, const int g, float (&m_run)[2], float (&l_run)[2], f32x4 (&O)[DV / 16][2]) {
    constexpr int KROWB = DK * 2, VROWB = DV * 2 + 32, NS = DK / 32, NDB = DV / 16;
    const float base = (m_run[RB] > -1e29f) ? m_run[RB] : 0.f;
    f32x4 S[4];
#pragma unroll
    for (int kb = 0; kb < 4; ++kb) S[kb] = (f32x4){-base, -base, -base, -base};
    {
        constexpr int KLA = 8;
        bf16x8 fr[NS * 4];
#define S16_KADDR(f_) (((((f_) >> 2) & 1) ? kO : kE) + ((f_) & 3) * 16 * KROWB + 128 * ((f_) >> 3))
#pragma unroll
        for (int f = 0; f < KLA; ++f) fr[f] = *(const LAS bf16x8*)S16_KADDR(f);
#pragma unroll
        for (int f = 0; f < NS * 4; ++f) {
            if (f + KLA < NS * 4) fr[f + KLA] = *(const LAS bf16x8*)S16_KADDR(f + KLA);
            S[f & 3] = __builtin_amdgcn_mfma_f32_16x16x32_bf16(fr[f], qf[RB][f >> 2], S[f & 3], 0, 0, 0);
        }
        __builtin_amdgcn_sched_group_barrier(0x100, KLA, 0);
#pragma unroll
        for (int f = 0; f < NS * 4; ++f) { __builtin_amdgcn_sched_group_barrier(0x008, 1, 0); if (f + KLA < NS * 4) __builtin_amdgcn_sched_group_barrier(0x100, 1, 0); }
#undef S16_KADDR
    }
    constexpr int NSTEP = NDB * 2, VLA = 4;
    s16x4 vlo[NSTEP], vhi[NSTEP];
#define S16_VOFF(k_) ((32 * ((k_) & 1)) * VROWB + 32 * ((k_) >> 1))
#pragma unroll
    for (int k = 0; k < VLA; ++k) { vlo[k] = __builtin_amdgcn_ds_read_tr16_b64_v4i16((LAS s16x4*)(vb + S16_VOFF(k))); vhi[k] = __builtin_amdgcn_ds_read_tr16_b64_v4i16((LAS s16x4*)(vb + S16_VOFF(k) + 16 * VROWB)); }
    __builtin_amdgcn_sched_barrier(0);
    if (diag || !__all(on)) { const int dq = qhi - kbase - 4 * g;
#pragma unroll
        for (int kb = 0; kb < 4; ++kb)
#pragma unroll
            for (int j = 0; j < 4; ++j) if (!(on && (dq - 16 * kb - j) >= 0)) S[kb][j] = NEG_INF_F; }
    float m_ = S[0][0];
#pragma unroll
    for (int kb = 0; kb < 4; ++kb)
#pragma unroll
        for (int j = 0; j < 4; ++j) m_ = fmaxf(m_, S[kb][j]);
    const float tmax = xchg_max32(xchg_max16(m_));
    if (!__all(tmax + (base - m_run[RB]) <= ATT_THR)) {
        const float mn = fmaxf(m_run[RB], tmax + base); const float alpha = __builtin_amdgcn_exp2f(m_run[RB] - mn); const float dsh = mn - base;
        m_run[RB] = mn; l_run[RB] *= alpha;
#pragma unroll
        for (int kb = 0; kb < 4; ++kb) S[kb] = S[kb] - dsh;
#pragma unroll
        for (int db = 0; db < NDB; ++db) O[db][RB] = O[db][RB] * alpha;
    }
    float rs = 0.f;
#pragma unroll
    for (int kb = 0; kb < 4; ++kb)
#pragma unroll
        for (int j = 0; j < 4; ++j) { S[kb][j] = __builtin_amdgcn_exp2f(S[kb][j]); rs += S[kb][j]; }
    l_run[RB] += xchg_add32(xchg_add16(rs));
    bf16x8 pb[2];
#pragma unroll
    for (int m = 0; m < 2; ++m) { const u32x4 w = pack8f(S[2 * m], S[2 * m + 1]); pb[m] = *reinterpret_cast<const bf16x8*>(&w); }
    {
#pragma unroll
        for (int k = 0; k < NSTEP; ++k) {
            if (k + VLA < NSTEP) { vlo[k + VLA] = __builtin_amdgcn_ds_read_tr16_b64_v4i16((LAS s16x4*)(vb + S16_VOFF(k + VLA))); vhi[k + VLA] = __builtin_amdgcn_ds_read_tr16_b64_v4i16((LAS s16x4*)(vb + S16_VOFF(k + VLA) + 16 * VROWB)); }
            const bf16x8 av = {vlo[k][0], vlo[k][1], vlo[k][2], vlo[k][3], vhi[k][0], vhi[k][1], vhi[k][2], vhi[k][3]};
            O[k >> 1][RB] = __builtin_amdgcn_mfma_f32_16x16x32_bf16(av, pb[k & 1], O[k >> 1][RB], 0, 0, 0);
        }
#pragma unroll
        for (int k = 0; k < NSTEP; ++k) { __builtin_amdgcn_sched_group_barrier(0x008, 1, 1); if (k + VLA < NSTEP) __builtin_amdgcn_sched_group_barrier(0x100, 2, 1); }
#undef S16_VOFF
    }
}
template <int DK, int DV>
__device__ __forceinline__ void attn_sel16(LAS unsigned char* lds, const AttnSrc src, const int j_hi, const bf16x8 (&qf)[2][DK / 32], const int (&qhi)[2], const int qmin_w,
                                           const LAS unsigned* sel0, const LAS unsigned* sel1, const LAS unsigned* selrb, float (&m_run)[2], float (&l_run)[2], f32x4 (&O)[DV / 16][2]) {
    constexpr int KROWB = DK * 2, VROWB = DV * 2 + 32, KBUF = 64 * KROWB, VBUF = 64 * VROWB;
    constexpr int KCPR = DK / 8, VCPR = DV / 8, KN = (64 * KCPR) / 512, VN = (64 * VCPR) / 512;
    static_assert((64 * KCPR) % 512 == 0 && (64 * VCPR) % 512 == 0 && KCPR % 8 == 0, "attn_sel16: tile shapes");
    const int tid = opaque_tid(), lane = tid & 63, c = lane & 15, g = lane >> 4;
    const int nt = j_hi;
    if (nt <= 0) return;
    LAS unsigned char* Kb = lds; LAS unsigned char* Vb = lds + 2 * KBUF;
    unsigned koff[KN], klds[KN], voff[VN], vlds[VN];
#pragma unroll
    for (int i = 0; i < KN; ++i) { const int id = tid + 512 * i, row = id / KCPR, ch = id % KCPR; koff[i] = (unsigned)(row * src.ks + ch * 8); klds[i] = (unsigned)(row * KROWB + ((ch ^ ((row >> 1) & 7)) * 16)); }
#pragma unroll
    for (int i = 0; i < VN; ++i) { const int id = tid + 512 * i, row = id / VCPR, ch = id % VCPR; voff[i] = (unsigned)(row * src.vs + ch * 8); vlds[i] = (unsigned)(row * VROWB + ch * 16); }
    bf16x8 sk[KN], sv[VN];
#define S16_ISSUE(t_) do { const GAS bf16_t* kp_ = (const GAS bf16_t*)src.K + (size_t)(t_) * 64 * src.ks; const GAS bf16_t* vp_ = (const GAS bf16_t*)src.V + (size_t)(t_) * 64 * src.vs; \
        _Pragma("unroll") for (int i = 0; i < KN; ++i) sk[i] = *(const GAS bf16x8*)(kp_ + koff[i]); \
        _Pragma("unroll") for (int i = 0; i < VN; ++i) sv[i] = *(const GAS bf16x8*)(vp_ + voff[i]); } while (0)
#define S16_WRITE(b_) do { \
        _Pragma("unroll") for (int i = 0; i < KN; ++i) *(LAS bf16x8*)(Kb + (b_) * KBUF + klds[i]) = sk[i]; \
        _Pragma("unroll") for (int i = 0; i < VN; ++i) *(LAS bf16x8*)(lds + 3 * KBUF + (b_) * VBUF + vlds[i]) = sv[i]; } while (0)
    __syncthreads();
    S16_ISSUE(0); S16_WRITE(0);
    __syncthreads();
    const int kswz = (c >> 1) & 7;
    const int kbE = c * KROWB + 16 * (g ^ kswz), kbO = c * KROWB + 16 * ((4 + g) ^ kswz);
    const int q4 = (lane >> 2) & 3, p4 = lane & 3;
    const int vlane = (4 * g + q4) * VROWB + 8 * p4;
    LAS unsigned char* Vr = lds + 3 * KBUF;
#define S16_RUN(RB_, t_, slot_) do { const int tt_ = (t_), kbase = 64 * tt_; const bool diag = (kbase + 63 > qmin_w); \
        const bool on_ = ((((RB_) == 0 ? sel0 : sel1)[tt_ >> 5] >> (tt_ & 31)) & 1u) != 0u; \
        const LAS unsigned char* kE = Kb + (slot_) * KBUF + kbE; const LAS unsigned char* kO = Kb + (slot_) * KBUF + kbO; const LAS unsigned char* vb = Vr + (slot_) * VBUF + vlane; \
        sel16_rb<DK, DV, RB_>(kE, kO, vb, qf, qhi[RB_], kbase, diag, on_, g, m_run, l_run, O); } while (0)
    int slot = 0, pslot = 2; bool deferred = false;
    for (int it = 0; it < nt; ++it) {
        const int t = it, nslot = (slot == 2) ? 0 : slot + 1;
        if (it + 1 < nt) S16_ISSUE(t + 1);
        const unsigned ub0 = (unsigned)__builtin_amdgcn_readfirstlane((int)selrb[t >> 5]), ub1 = (unsigned)__builtin_amdgcn_readfirstlane((int)selrb[8 + (t >> 5)]);
        const bool a0 = ((ub0 >> (t & 31)) & 1u) != 0u, a1 = ((ub1 >> (t & 31)) & 1u) != 0u;
        const bool dprev = deferred;
        if (dprev) S16_RUN(1, t - 1, pslot);
        if (a0) S16_RUN(0, t, slot);
        deferred = a1 && (a0 || dprev);
        if (a1 && !deferred) S16_RUN(1, t, slot);
        if (it + 1 < nt) S16_WRITE(nslot);
        __syncthreads();
        pslot = slot; slot = nslot;
    }
    if (deferred) S16_RUN(1, nt - 1, pslot);
#undef S16_RUN
#undef S16_ISSUE
#undef S16_WRITE
}
__device__ __forceinline__ void mla_item(LAS unsigned char* lds, unsigned char* ws, int b, int hd, int qb, size_t obase = B_OMLA) {
    const int tid = opaque_tid(), wv = __builtin_amdgcn_readfirstlane(tid >> 6), lane = tid & 63, r = lane & 31, h = lane >> 5;
    const int pos = 256 * qb + 32 * wv + r; const size_t tok = (size_t)b * SEQ + pos;
    const bf16_t* qrow = (const bf16_t*)(ws + B_QM) + tok * 1152 + hd * 192;
    bf16x8 qf[12];
#pragma unroll
    for (int s = 0; s < 12; ++s) qf[s] = *(const GAS bf16x8*)((const GAS bf16_t*)qrow + 16 * s + 8 * h);
    AttnSrc src; src.K = (const bf16_t*)(ws + B_KM) + (size_t)b * SEQ * 1152 + hd * 192; src.ks = 1152; src.V = (const bf16_t*)(ws + B_VM) + (size_t)b * SEQ * 768 + hd * 128; src.vs = 768;
    float m_run = -1e30f, l_run = 0.f; f32x16 O[4]; zero_o<4>(O);
    attn_core<192, 128, 0>(lds, src, 0, 4 * (qb + 1), qf, pos, 0x7fffffffu, 256 * qb + 32 * wv, 256 * qb + 32 * wv + 31, m_run, l_run, O, nullptr, nullptr, 0.f, nullptr, nullptr);
    const float il = l_run > 0.f ? 1.0f / l_run : 0.f;
    store_row<4>((bf16_t*)(ws + obase) + tok * 768 + hd * 128, O, il, h);
}
__device__ __forceinline__ void diff_item(LAS unsigned char* lds, unsigned char* ws, int b, int hd, int qb, float lam, float lam_init, const float* subln) {
    const int tid = opaque_tid(), wv = __builtin_amdgcn_readfirstlane(tid >> 6), lane = tid & 63, r = lane & 31, h = lane >> 5;
    const int pos = 256 * qb + 32 * wv + r; const size_t tok = (size_t)b * SEQ + pos;
    bf16_t* orow = (bf16_t*)(ws + B_ODIFF) + tok * 768 + hd * 192;
#pragma unroll 1
    for (int sub = 0; sub < 2; ++sub) {
        const bf16_t* qrow = (const bf16_t*)(ws + B_DQ) + tok * 768 + (2 * hd + sub) * 96;
        bf16x8 qf[6];
#pragma unroll
        for (int s = 0; s < 6; ++s) qf[s] = *(const GAS bf16x8*)((const GAS bf16_t*)qrow + 16 * s + 8 * h);
        AttnSrc src; src.K = (const bf16_t*)(ws + B_DK) + (size_t)b * SEQ * 768 + (2 * hd + sub) * 96; src.ks = 768; src.V = (const bf16_t*)(ws + B_DV) + (size_t)b * SEQ * 768 + hd * 192; src.vs = 768;
        float m_run = -1e30f, l_run = 0.f; f32x16 O[6]; zero_o<6>(O);
        attn_core<96, 192, 0>(lds, src, 0, 4 * (qb + 1), qf, pos, 0x7fffffffu, 256 * qb + 32 * wv, 256 * qb + 32 * wv + 31, m_run, l_run, O, nullptr, nullptr, 0.f, nullptr, nullptr);
        const float il = l_run > 0.f ? 1.0f / l_run : 0.f;
        if (sub == 0) { store_row<6>(orow, O, il, h); }
        else {
            float ss = 0.f;
#pragma unroll
            for (int db = 0; db < 6; ++db)
#pragma unroll
                for (int i4 = 0; i4 < 4; ++i4) { const u32x2 o = *(const u32x2*)(orow + 32 * db + 8 * i4 + 4 * h);
                    const float a0 = bf_lo(o.x) - lam * O[db][4 * i4] * il, a1 = bf_hi(o.x) - lam * O[db][4 * i4 + 1] * il, a2 = bf_lo(o.y) - lam * O[db][4 * i4 + 2] * il, a3 = bf_hi(o.y) - lam * O[db][4 * i4 + 3] * il;
                    O[db][4 * i4] = a0; O[db][4 * i4 + 1] = a1; O[db][4 * i4 + 2] = a2; O[db][4 * i4 + 3] = a3; ss += (a0 * a0 + a1 * a1) + (a2 * a2 + a3 * a3); }
            ss += __shfl_xor(ss, 32);
            const float rstd = (1.0f / sqrtf(ss * (1.0f / 192.0f) + EPS)) * (1.0f - lam_init);
#pragma unroll
            for (int db = 0; db < 6; ++db)
#pragma unroll
                for (int i4 = 0; i4 < 4; ++i4) { const int d0 = 32 * db + 8 * i4 + 4 * h; const f32x4 g = *(const f32x4*)(subln + d0); u32x2 w;
                    w.x = cvt_pk_bf16(O[db][4 * i4] * rstd * g[0], O[db][4 * i4 + 1] * rstd * g[1]); w.y = cvt_pk_bf16(O[db][4 * i4 + 2] * rstd * g[2], O[db][4 * i4 + 3] * rstd * g[3]);
                    *(u32x2*)(orow + d0) = w; }
        }
    }
}
__device__ __forceinline__ void nsa_item(LAS unsigned char* lds, unsigned char* ws, int b, int qt) {
    const int tid = opaque_tid(), wv = __builtin_amdgcn_readfirstlane(tid >> 6), lane = tid & 63, r = lane & 31, h = lane >> 5;
    const int q0 = 64 * qt, ql = r & 7, hd = r >> 3, pos = q0 + 8 * wv + ql; const size_t tok = (size_t)b * SEQ + pos;
    const int cur = qt;
    const bf16_t* qrow = (const bf16_t*)(ws + B_NQ) + tok * 768 + hd * 192;
    bf16x8 qf[12];
#pragma unroll
    for (int s = 0; s < 12; ++s) qf[s] = *(const GAS bf16x8*)((const GAS bf16_t*)qrow + 16 * s + 8 * h);
    const float* gp = (const float*)(ws + B_NGATE) + tok * 16 + hd * 3;
    const float g_c = gp[0], g_s = gp[1], g_w = gp[2];
    bf16_t* orow = (bf16_t*)(ws + B_ONSA) + tok * 512 + hd * 128;
    LAS float* strip = (LAS float*)(lds + NSA_STRIP_OFF) + wv * (8 * 68);
    LAS float* impw = (LAS float*)(lds + NSA_IMP_OFF) + wv * (8 * 256);
    LAS unsigned* selm = (LAS unsigned*)(lds + NSA_SEL_OFF) + wv * 64;
    LAS unsigned* uni = (LAS unsigned*)(lds + NSA_UNI_OFF) + wv * 8;
    f32x16 O[4];
    const int qc = (pos - 31) >> 4, qc_min = (q0 + 8 * wv - 31) >> 4, qc_max = (q0 + 8 * wv + 7 - 31) >> 4;
    const int jc_hi = ((q0 + 32) >> 10) + 1;
    AttnSrc sc; sc.K = (const bf16_t*)(ws + B_KC) + (size_t)b * 1024 * 192; sc.ks = 192; sc.V = (const bf16_t*)(ws + B_VC) + (size_t)b * 1024 * 128; sc.vs = 128;
    float m_c = -1e30f, l_c = 0.f; zero_o<4>(O);
    attn_core<192, 128, 0>(lds, sc, 0, jc_hi, qf, qc, 0x7fffffffu, qc_min, qc_max, m_c, l_c, O, nullptr, nullptr, 0.f, nullptr, nullptr);
    const float il_c = l_c > 0.f ? 1.0f / l_c : 0.f;
    store_row<4>(orow, O, il_c * g_c, h);
    if (cur >= 16) {
        if (lane < 8) strip[lane * 68 + 3] = 0.f;
        float dm = m_c, dl = 0.f;
        attn_core<192, 128, 2>(lds, sc, 0, jc_hi, qf, qc, 0x7fffffffu, qc_min, qc_max, dm, dl, O, nullptr, nullptr, il_c, strip, impw);
        unsigned un[8] = {0u, 0u, 0u, 0u, 0u, 0u, 0u, 0u};
#pragma unroll 1
        for (int q0_ = 0; q0_ < 8; q0_ += 4) {
            unsigned uk[4][4]; bool cd[4], fl0[4];
#pragma unroll
            for (int k = 0; k < 4; ++k) { const int j = lane + 64 * k; cd[k] = (j >= 1) && (j <= cur - 2); fl0[k] = (j == 0) || (j == cur) || (j == cur - 1);
#pragma unroll
                for (int u = 0; u < 4; ++u) uk[u][k] = cd[k] ? __float_as_uint(impw[(q0_ + u) * 256 + j]) : 0u; }
            unsigned Tv[4] = {0u, 0u, 0u, 0u}; int cv[4] = {1 << 20, 1 << 20, 1 << 20, 1 << 20};
#pragma unroll 1
            for (int bit = 30; bit >= 0; --bit) {
#pragma unroll
                for (int u = 0; u < 4; ++u) { const unsigned Tt = Tv[u] | (1u << bit); int cnt = 0;
#pragma unroll
                    for (int k = 0; k < 4; ++k) cnt += __builtin_popcountll(__ballot(cd[k] && uk[u][k] >= Tt));
                    if (cnt >= 13) { Tv[u] = Tt; cv[u] = cnt; } }
                if (cv[0] == 13 && cv[1] == 13 && cv[2] == 13 && cv[3] == 13) break; }
#pragma unroll
            for (int u = 0; u < 4; ++u) { const int q = q0_ + u; bool fl[4];
#pragma unroll
                for (int k = 0; k < 4; ++k) fl[k] = fl0[k];
                int ngt = 0;
#pragma unroll
                for (int k = 0; k < 4; ++k) ngt += __builtin_popcountll(__ballot(cd[k] && uk[u][k] > Tv[u]));
                int need = 13 - ngt;
#pragma unroll
                for (int k = 0; k < 4; ++k) { const bool eq = cd[k] && uk[u][k] == Tv[u]; const unsigned long long bm = __ballot(eq);
                    const int rank = __builtin_popcountll(bm & ((1ull << lane) - 1ull));
                    if (cd[k] && (uk[u][k] > Tv[u] || (eq && rank < need))) fl[k] = true;
                    need -= __builtin_popcountll(bm); }
#pragma unroll
                for (int k = 0; k < 4; ++k) { const unsigned long long bm = __ballot(fl[k]); const unsigned lo = (unsigned)bm, hi2 = (unsigned)(bm >> 32);
                    if (lane == 0) { selm[q * 8 + 2 * k] = lo; selm[q * 8 + 2 * k + 1] = hi2; } un[2 * k] |= lo; un[2 * k + 1] |= hi2; } }
        }
        if (lane == 0) {
#pragma unroll
            for (int k = 0; k < 8; ++k) uni[k] = un[k]; }
    } else {
        if (lane < 8) {
#pragma unroll
            for (int k = 0; k < 8; ++k) selm[lane * 8 + k] = (k == 0) ? ((1u << (cur + 1)) - 1u) : 0u; }
        if (lane == 0) {
#pragma unroll
            for (int k = 0; k < 8; ++k) uni[k] = (k == 0) ? ((1u << (cur + 1)) - 1u) : 0u; }
    }
    asm volatile("s_waitcnt lgkmcnt(0)" ::: "memory");
    {
        const int c16 = lane & 15, g16 = lane >> 4;
        LAS unsigned* urb = (LAS unsigned*)(lds + NSA_URB_OFF) + wv * 16;
        if (lane < 16) { const int rb_ = lane >> 3, k_ = lane & 7; urb[lane] = (selm[(4 * rb_ + 0) * 8 + k_] | selm[(4 * rb_ + 1) * 8 + k_]) | (selm[(4 * rb_ + 2) * 8 + k_] | selm[(4 * rb_ + 3) * 8 + k_]); }
        asm volatile("s_waitcnt lgkmcnt(0)" ::: "memory");
        AttnSrc ss; ss.K = (const bf16_t*)(ws + B_KSLC) + (size_t)b * SEQ * 192; ss.ks = 192; ss.V = (const bf16_t*)(ws + B_VSLC) + (size_t)b * SEQ * 128; ss.vs = 128;
        bf16x8 q16[2][6]; int qh16[2];
#pragma unroll
        for (int rb = 0; rb < 2; ++rb) { const int ql_ = 4 * rb + (c16 & 3), hd_ = c16 >> 2, pos_ = q0 + 8 * wv + ql_; const size_t tok_ = (size_t)b * SEQ + pos_;
            const GAS bf16_t* qrow_ = (const GAS bf16_t*)(ws + B_NQ) + tok_ * 768 + hd_ * 192;
#pragma unroll
            for (int s = 0; s < 6; ++s) q16[rb][s] = *(const GAS bf16x8*)(qrow_ + 32 * s + 8 * g16);
            qh16[rb] = pos_; }
        float m16[2] = {-1e30f, -1e30f}, l16[2] = {0.f, 0.f}; f32x4 O16[8][2];
#pragma unroll
        for (int db = 0; db < 8; ++db)
#pragma unroll
            for (int rb = 0; rb < 2; ++rb) O16[db][rb] = (f32x4){0.f, 0.f, 0.f, 0.f};
        attn_sel16<192, 128>(lds, ss, cur + 1, q16, qh16, q0 + 8 * wv, selm + (c16 & 3) * 8, selm + (4 + (c16 & 3)) * 8, urb, m16, l16, O16);
        __builtin_amdgcn_fence(__ATOMIC_SEQ_CST, "workgroup");
#pragma unroll
        for (int rb = 0; rb < 2; ++rb) { const int lane_ = opaque_tid() & 63, c_ = lane_ & 15, ql_ = 4 * rb + (c_ & 3), hd_ = c_ >> 2; const size_t tok_ = (size_t)b * SEQ + q0 + 8 * wv + ql_;
            const float sc_ = (l16[rb] > 0.f ? 1.0f / l16[rb] : 0.f) * ((const float*)(ws + B_NGATE))[tok_ * 16 + hd_ * 3 + 1];
            bf16_t* orow_ = (bf16_t*)(ws + B_ONSA) + tok_ * 512 + hd_ * 128 + 4 * (lane_ >> 4);
#pragma unroll
            for (int db = 0; db < 8; ++db) { GAS u32x2* p = (GAS u32x2*)(orow_ + 16 * db); const u32x2 o = *p; u32x2 w;
                w.x = cvt_pk_bf16(bf_lo(o.x) + O16[db][rb][0] * sc_, bf_hi(o.x) + O16[db][rb][1] * sc_);
                w.y = cvt_pk_bf16(bf_lo(o.y) + O16[db][rb][2] * sc_, bf_hi(o.y) + O16[db][rb][3] * sc_); *p = w; } }
        __builtin_amdgcn_fence(__ATOMIC_SEQ_CST, "workgroup");
#pragma unroll
        for (int s = 0; s < 12; ++s) qf[s] = *(const GAS bf16x8*)((const GAS bf16_t*)qrow + 16 * s + 8 * h);
    }
    {
        AttnSrc sw; sw.K = (const bf16_t*)(ws + B_KWIN) + (size_t)b * SEQ * 192; sw.ks = 192; sw.V = (const bf16_t*)(ws + B_VWIN) + (size_t)b * SEQ * 128; sw.vs = 128;
        const int lo = q0 - 511; const int j_lo = lo > 0 ? (lo >> 6) : 0;
        float m_w = -1e30f, l_w = 0.f; zero_o<4>(O);
        attn_core<192, 128, 0>(lds, sw, j_lo, cur + 1, qf, pos, 512u, q0 + 8 * wv, q0 + 8 * wv + 7, m_w, l_w, O, nullptr, nullptr, 0.f, nullptr, nullptr);
        const float il = l_w > 0.f ? 1.0f / l_w : 0.f;
        accum_row<4>(orow, O, il * g_w, h);
    }
}

struct Args { const float* in[29]; float* out; unsigned char* ws; int ph_lo, ph_hi; };
constexpr int PH_PER_LAYER = 15, PH_FINAL = DEPTH * PH_PER_LAYER, PH_TOTAL = PH_FINAL + 1;

__device__ __forceinline__ int q_fetch(unsigned* ctr, volatile LAS unsigned* misc) {
    __syncthreads();
    if (threadIdx.x == 0) misc[4] = __hip_atomic_fetch_add(ctr, 1u, __ATOMIC_RELAXED, __HIP_MEMORY_SCOPE_AGENT);
    __syncthreads();
    return (int)misc[4];
}

__global__ void __launch_bounds__(512, 2) mk_fwd(Args args) {
    extern __shared__ __attribute__((aligned(16))) unsigned char lds_raw[];
    LAS unsigned char* lds = (LAS unsigned char*)lds_raw;
    volatile LAS unsigned* misc = (volatile LAS unsigned*)(lds + MISC_OFF);
    unsigned char* const ws0 = args.ws;
    unsigned* ctl = g_ctl;
    if (threadIdx.x < 16) misc[threadIdx.x] = 0u;
    __syncthreads();
    XcdBarrier bar; bar.bar = ctl + CW_BAR; bar.x = 0; bar.st = misc;
    if (!MK_SPLIT) bar = xcd_barrier_post(ctl + CW_BAR, misc);
    const int lo = args.ph_lo, hi = args.ph_hi;
#ifndef MK_LAST_PHASE
#define MK_LAST_PHASE 1000
#endif
#define IN(k) (lo <= (k) && (k) < hi && ((k) <= MK_LAST_PHASE || (k) == PH_FINAL))
#define SEAM(k) do { if ((k) + 1 < hi) xcd_barrier(bar); } while (0)
    float* xres = args.out;
#define PHASE_LOCALS \
    const int tid = opaque_tid(), lane = tid & 63, wave = __builtin_amdgcn_readfirstlane(tid >> 6); \
    int G = gridDim.x, bx = blockIdx.x; asm volatile("" : "+s"(G), "+s"(bx)); \
    const int gw = bx * 8 + wave, ngw = G * 8; (void)gw; (void)ngw; (void)lane; \
    unsigned char* ws = ws0; asm volatile("" : "+s"(ws)); \
    bf16_t* NB = (bf16_t*)(ws + WS_NBUF); bf16_t* ACT = (bf16_t*)(ws + B_ACT); const float* tab = (const float*)(ws + WS_ROPE); (void)NB; (void)ACT; (void)tab; \
    LAS float* scr = (LAS float*)(lds + wave * 16384); (void)scr; \
    const char __attribute__((address_space(4)))* kargp = (const char __attribute__((address_space(4)))*)__builtin_amdgcn_kernarg_segment_ptr(); asm volatile("" : "+s"(kargp)); (void)kargp;
#define AIN(k) (*(const float* const __attribute__((address_space(4)))*)(kargp + 8 * (k)))

    if (IN(0)) {
        PHASE_LOCALS
        float* tw = (float*)(ws + WS_ROPE);
        for (int i = bx * 512 + tid; i < SEQ * NTAB; i += G * 512) { float c, s; rope_entry(i / NTAB, i % NTAB, c, s); tw[2 * (size_t)i] = c; tw[2 * (size_t)i + 1] = s; }
        u64* stz = (u64*)(ws + WS_STATS);
        for (int i = bx * 512 + tid + T; i < 6 * T; i += G * 512) stz[i] = 0ull;
    }
#pragma unroll 1
    for (int l = 0; l < DEPTH; ++l) {
        const int pb = l * PH_PER_LAYER;
        const float* xin = args.in[0];
        if (IN(pb + 0)) {
            PHASE_LOCALS
            for (int rep_ = 0; rep_ < (int)((DUPMASK >> 0) & 1u) + 1; ++rep_) {
            conv_job(AIN(2) + (size_t)l * D * 2 * DFF, D, 2 * DFF, MAP_FFN_IN, 0, (bf16_t*)(ws + W_FFN_IN), 2 * DFF, scr, gw, ngw, lane, false, AIN(1) + (size_t)l * D);
            conv_job(AIN(3) + (size_t)l * DFF * D, DFF, D, MAP_ID, 0, (bf16_t*)(ws + W_FFN_OUT), D, scr, gw, ngw, lane);
            conv_job(AIN(5) + (size_t)l * D * DIN, D, DIN, MAP_PROJ, 0, (bf16_t*)(ws + W_PROJ), NPROJ, scr, gw, ngw, lane, false, AIN(4) + (size_t)l * D);
            conv_job(AIN(5) + (size_t)l * D * DIN, D, DIN, MAP_GATE, 0, (bf16_t*)(ws + W_GATE), 6144, scr, gw, ngw, lane, false, AIN(4) + (size_t)l * D);
            conv_job(AIN(8) + (size_t)l * 768 * 1152, 768, 1152, MAP_UQ, 0, (bf16_t*)(ws + W_UQ), 1280, scr, gw, ngw, lane);
            conv_job(AIN(9) + (size_t)l * 512 * 1536, 512, 1536, MAP_ID, 0, (bf16_t*)(ws + W_UKV), 1536, scr, gw, ngw, lane);
            conv_job(AIN(11) + (size_t)l * 6144 * 256, 6144, 256, MAP_ID, 0, (bf16_t*)(ws + W_CK1), 256, scr, gw, ngw, lane, true);
            conv_job(AIN(12) + (size_t)l * 256 * 192, 256, 192, MAP_ROPE192, 192, (bf16_t*)(ws + W_CK2), 256, scr, gw, ngw, lane);
            conv_job(AIN(14) + (size_t)l * 4096 * 256, 4096, 256, MAP_ID, 0, (bf16_t*)(ws + W_CV1), 256, scr, gw, ngw, lane);
            conv_job(AIN(15) + (size_t)l * 256 * 128, 256, 128, MAP_PADN, 128, (bf16_t*)(ws + W_CV2), 256, scr, gw, ngw, lane);
            conv_job(AIN(21) + (size_t)l * 768 * D, 768, D, MAP_ID, 0, (bf16_t*)(ws + W_BRM), D, scr, gw, ngw, lane);
            conv_job(AIN(22) + (size_t)l * 512 * D, 512, D, MAP_ID, 0, (bf16_t*)(ws + W_BRN), D, scr, gw, ngw, lane);
            conv_job(AIN(23) + (size_t)l * 768 * D, 768, D, MAP_ID, 0, (bf16_t*)(ws + W_BRD), D, scr, gw, ngw, lane);
            conv_job(AIN(24) + (size_t)l * D * D, D, D, MAP_ID, 0, (bf16_t*)(ws + W_OUT), D, scr, gw, ngw, lane);
            if (l == 0) { u64* st0 = (u64*)(ws + WS_STATS); for (int mrow = gw; mrow < T; mrow += ngw) xb_row_stats(xin + (size_t)mrow * D, NB + (size_t)mrow * D, st0 + mrow, lane); }
            if (bx < 64) {
                float* part = (float*)(ws + WS_BIASP);
                const int isv = tid >> 8, n = tid & 255;
                const int rows = isv ? 64 : 96; const int r0 = bx * rows;
                const float* pp = (isv ? AIN(13) + (size_t)l * 4096 : AIN(10) + (size_t)l * 6144) + r0;
                const float* wp = (isv ? AIN(14) + (size_t)l * 4096 * 256 : AIN(11) + (size_t)l * 6144 * 256) + (size_t)r0 * 256 + n;
                float a = 0.f;
                for (int rr = 0; rr < rows; ++rr) a += pp[rr] * wp[(size_t)rr * 256];
                part[(isv * 64 + bx) * 256 + n] = a;
            }
            }
            SEAM(pb + 0);
        }
        if (IN(pb + 1)) {
            PHASE_LOCALS
            for (int rep_ = 0; rep_ < (int)((DUPMASK >> 1) & 1u) + 1; ++rep_) {
            pg8::Gemm g{NB, (const bf16_t*)(ws + W_FFN_IN), T, 2 * DFF, D, D, D}; pg8::StaticOrder S; S.init(T, 2 * DFF, G, bx);
            EpiSwiglu E{ACT, DFF, (const u64*)(ws + WS_STATS) + (size_t)(l * 3 + 0) * T};
            pg8::gemm_phase<EpiSwiglu, pg8::StaticOrder>(lds, g, S, E);
            }
            SEAM(pb + 1);
        }
        if (IN(pb + 2)) {
            PHASE_LOCALS
            for (int rep_ = 0; rep_ < (int)((DUPMASK >> 2) & 1u) + 1; ++rep_) {
            pg8::Gemm g{ACT, (const bf16_t*)(ws + W_FFN_OUT), T, D, DFF, DFF, DFF}; pg8::StaticOrder S; S.init(T, D, G, bx);
            EpiResid E{NB, 0.5f, (u64*)(ws + WS_STATS) + (size_t)(l * 3 + 1) * T};
            pg8::gemm_phase<EpiResid, pg8::StaticOrder>(lds, g, S, E);
            }
            SEAM(pb + 2);
        }
        if (IN(pb + 4)) {
            PHASE_LOCALS
            for (int rep_ = 0; rep_ < (int)((DUPMASK >> 4) & 1u) + 1; ++rep_) {
            pg8::Gemm g{NB, (const bf16_t*)(ws + W_PROJ), T, NPROJ, D, D, D}; pg8::StaticOrder S; S.init(T, NPROJ, G, bx);
            EpiProj E{ws, tab, (const u64*)(ws + WS_STATS) + (size_t)(l * 3 + 1) * T};
            pg8::gemm_phase<EpiProj, pg8::StaticOrder>(lds, g, S, E);
            }
            SEAM(pb + 4);
        }
        if (IN(pb + 5)) {
            PHASE_LOCALS
            for (int rep_ = 0; rep_ < (int)((DUPMASK >> 5) & 1u) + 1; ++rep_) {
            conv_job(AIN(26) + (size_t)l * D * 2 * DFF, D, 2 * DFF, MAP_FFN_IN, 0, (bf16_t*)(ws + W_FFN_IN), 2 * DFF, scr, gw, ngw, lane, false, AIN(25) + (size_t)l * D);
            conv_job(AIN(27) + (size_t)l * DFF * D, DFF, D, MAP_ID, 0, (bf16_t*)(ws + W_FFN_OUT), D, scr, gw, ngw, lane);
            for (int i = bx * 512 + tid; i < 16 * 192; i += G * 512) ((bf16_t*)(ws + B_KCMP))[(size_t)T * 192 + i] = 0;
            for (int i = bx * 512 + tid; i < 16 * 128; i += G * 512) ((bf16_t*)(ws + B_VCMP))[(size_t)T * 128 + i] = 0;
            for (int mrow = gw; mrow < T; mrow += ngw) {
                rms_row_inplace_bf16<768>((bf16_t*)(ws + B_CQ) + (size_t)mrow * 768, AIN(6) + (size_t)l * 768, lane);
                rms_row_inplace_bf16<512>((bf16_t*)(ws + B_CKV) + (size_t)mrow * 512, AIN(7) + (size_t)l * 512, lane);
            }
            if (bx == 0) { const float* part = (const float*)(ws + WS_BIASP); float* bias = (float*)(ws + WS_BIASP) + 2 * 64 * 256;
                const int isv = tid >> 8, n = tid & 255; float a = 0.f;
                for (int j = 0; j < 64; ++j) a += part[(isv * 64 + j) * 256 + n];
                bias[isv * 256 + n] = a; }
            }
            SEAM(pb + 5);
        }
        if (IN(pb + 6)) {
            PHASE_LOCALS
            for (int rep_ = 0; rep_ < (int)((DUPMASK >> 6) & 1u) + 1; ++rep_) {
            if (bx < 16 && G > 16) {
                const bool isv = bx >= 8; const int c8 = bx & 7;
                const float* bias = (const float*)(ws + WS_BIASP) + 2 * 64 * 256 + (isv ? 256 : 0);
                { pg8::Gemm g{(const bf16_t*)(ws + (isv ? B_VCMP : B_KCMP)), (const bf16_t*)(ws + (isv ? W_CV1 : W_CK1)), 2048, 256, isv ? 4096 : 6144, isv ? 16 * 128 : 16 * 192, isv ? 4096 : 6144};
                  pg8::StaticOrder S; S.init(2048, 256, 8, c8);
                  EpiBf16<2> E{(bf16_t*)(ws + (isv ? B_HIDV : B_HIDK)), 256, 256, bias, nullptr}; pg8::gemm_phase<EpiBf16<2>, pg8::StaticOrder>(lds, g, S, E); }
                { pg8::Gemm g{(const bf16_t*)(ws + (isv ? B_HIDV : B_HIDK)), (const bf16_t*)(ws + (isv ? W_CV2 : W_CK2)), 2048, 256, 256, 256, 256};
                  pg8::StaticOrder S; S.init(2048, 256, 8, c8);
                  EpiBf16<0> E{(bf16_t*)(ws + (isv ? B_VC : B_KC)), isv ? 128 : 192, isv ? 128 : 192, nullptr, nullptr}; pg8::gemm_phase<EpiBf16<0>, pg8::StaticOrder>(lds, g, S, E); }
            } else {
                const int Gm = (G > 16) ? G - 16 : G, cm = (G > 16) ? bx - 16 : bx;
                { pg8::Gemm g{(const bf16_t*)(ws + B_CQ), (const bf16_t*)(ws + W_UQ), T, 1280, 768, 768, 768}; pg8::StaticOrder S; S.init(T, 1280, Gm, cm);
                  EpiUq E{(bf16_t*)(ws + B_QM), tab}; pg8::gemm_phase<EpiUq, pg8::StaticOrder>(lds, g, S, E); }
                { pg8::Gemm g{(const bf16_t*)(ws + B_CKV), (const bf16_t*)(ws + W_UKV), T, 1536, 512, 512, 512}; pg8::StaticOrder S; S.init(T, 1536, Gm, cm);
                  EpiUkv E{(bf16_t*)(ws + B_KM), (bf16_t*)(ws + B_VM)}; pg8::gemm_phase<EpiUkv, pg8::StaticOrder>(lds, g, S, E); }
            }
            }
            SEAM(pb + 6);
        }
        if (IN(pb + 8)) {
            PHASE_LOCALS
            for (int rep_ = 0; rep_ < (int)((DUPMASK >> 8) & 1u) + 1; ++rep_) {
            float s1 = 0.f, s2 = 0.f;
            { const float* a1 = AIN(16) + l * 96; const float* b1 = AIN(17) + l * 96; const float* a2 = AIN(18) + l * 96; const float* b2 = AIN(19) + l * 96;
              for (int i = 0; i < 96; ++i) { s1 += a1[i] * b1[i]; s2 += a2[i] * b2[i]; } }
            const float lam_init = (l == 0) ? 0.2f : 0.35550906759096934f;
            const float lam = __builtin_amdgcn_exp2f(s1 * LOG2E) - __builtin_amdgcn_exp2f(s2 * LOG2E) + lam_init;
#ifndef DUP8
#define DUP8 1
#endif
#pragma unroll 1
            for (int rep = 0; rep < DUP8; ++rep) {
            unsigned* qd = ctl + CW_Q + 64 * (rep * 8 + l * 4 + 0); unsigned* qm = ctl + CW_Q + 64 * (rep * 8 + l * 4 + 1); unsigned* qn = ctl + CW_Q + 64 * (rep * 8 + l * 4 + 2);
#ifndef ONLY_MASK
#define ONLY_MASK 7
#endif
#ifdef STATIC_Q
#define QF(ctr, k_) (bx + (k_) * G)
#else
#define QF(ctr, k_) q_fetch(ctr, misc)
#endif
            for (int kq = 0;; ++kq) { const int idx = QF(qn, kq); if (idx >= 2 * 256 || ((rep == 0 ? ONLY_MASK : REP2_MASK) & 4) == 0) break;
                const int qt = 255 - idx / 2, b = idx % 2; nsa_item(lds, ws, b, qt); }
            for (int kq = 0;; ++kq) { const int idx = QF(qd, kq); if (idx >= 8 * 64 || ((rep == 0 ? ONLY_MASK : REP2_MASK) & 1) == 0) break;
                const int qb = 63 - idx / 8, bh = idx % 8; diff_item(lds, ws, bh >> 2, bh & 3, qb, lam, lam_init, AIN(20) + (size_t)l * 192); }
            for (int kq = 0;; ++kq) { const int idx = QF(qm, kq); if (idx >= 12 * 64 || ((rep == 0 ? ONLY_MASK : REP2_MASK) & 2) == 0) break;
                const int qb = 63 - idx / 12, bh = idx % 12; mla_item(lds, ws, bh / 6, bh % 6, qb); }
#ifdef DBG_TWICE
            for (int kq = 0;; ++kq) { const int idx = QF(qm, kq); if (idx >= 12 * 64) break;
                const int qb = 63 - idx / 12, bh = idx % 12; mla_item(lds, ws, bh / 6, bh % 6, qb, B_ODIFF); }
#endif
            __syncthreads();
            }
            }
            SEAM(pb + 8);
        }
        if (IN(pb + 9)) {
            PHASE_LOCALS
            for (int rep_ = 0; rep_ < (int)((DUPMASK >> 9) & 1u) + 1; ++rep_) {
            pg8::Gemm g{NB, (const bf16_t*)(ws + W_GATE), T, 6144, D, D, D}; pg8::StaticOrder S; S.init(T, 6144, G, bx);
            EpiBf16<1> E{(bf16_t*)(ws + B_G), 6144, 6144, nullptr, (const u64*)(ws + WS_STATS) + (size_t)(l * 3 + 1) * T};
            pg8::gemm_phase<EpiBf16<1>, pg8::StaticOrder>(lds, g, S, E);
            }
            SEAM(pb + 9);
        }
        if (IN(pb + 10)) {
            PHASE_LOCALS
            for (int rep_ = 0; rep_ < (int)((DUPMASK >> 10) & 1u) + 1; ++rep_) {
#ifndef BR_MASK
#define BR_MASK 7
#endif
            if (BR_MASK & 1) { pg8::Gemm g{(const bf16_t*)(ws + B_OMLA), (const bf16_t*)(ws + W_BRM), T, D, 768, 768, 768}; pg8::StaticOrder S; S.init(T, D, G, bx);
              EpiBranch E{(bf16_t*)(ws + WS_MIXB), (const bf16_t*)(ws + B_G), 0, 1}; pg8::gemm_phase<EpiBranch, pg8::StaticOrder>(lds, g, S, E); }
            if (BR_MASK & 2) { pg8::Gemm g{(const bf16_t*)(ws + B_ONSA), (const bf16_t*)(ws + W_BRN), T, D, 512, 512, 512}; pg8::StaticOrder S; S.init(T, D, G, bx);
              EpiBranch E{(bf16_t*)(ws + WS_MIXB), (const bf16_t*)(ws + B_G), 2048, (BR_MASK & 1) ? 0 : 1}; pg8::gemm_phase<EpiBranch, pg8::StaticOrder>(lds, g, S, E); }
            if (BR_MASK & 4) { pg8::Gemm g{(const bf16_t*)(ws + B_ODIFF), (const bf16_t*)(ws + W_BRD), T, D, 768, 768, 768}; pg8::StaticOrder S; S.init(T, D, G, bx);
              EpiBranch E{(bf16_t*)(ws + WS_MIXB), (const bf16_t*)(ws + B_G), 4096, (BR_MASK & 3) ? 0 : 1}; pg8::gemm_phase<EpiBranch, pg8::StaticOrder>(lds, g, S, E); }
            }
            SEAM(pb + 10);
        }
        if (IN(pb + 11)) {
            PHASE_LOCALS
            for (int rep_ = 0; rep_ < (int)((DUPMASK >> 11) & 1u) + 1; ++rep_) {
            pg8::Gemm g{(const bf16_t*)(ws + WS_MIXB), (const bf16_t*)(ws + W_OUT), T, D, D, D, D}; pg8::StaticOrder S; S.init(T, D, G, bx);
            EpiResid E{NB, 1.0f, (u64*)(ws + WS_STATS) + (size_t)(l * 3 + 2) * T};
            pg8::gemm_phase<EpiResid, pg8::StaticOrder>(lds, g, S, E);
            }
            SEAM(pb + 11);
        }
        if (IN(pb + 13)) {
            PHASE_LOCALS
            for (int rep_ = 0; rep_ < (int)((DUPMASK >> 13) & 1u) + 1; ++rep_) {
            pg8::Gemm g{NB, (const bf16_t*)(ws + W_FFN_IN), T, 2 * DFF, D, D, D}; pg8::StaticOrder S; S.init(T, 2 * DFF, G, bx);
            EpiSwiglu E{ACT, DFF, (const u64*)(ws + WS_STATS) + (size_t)(l * 3 + 2) * T};
            pg8::gemm_phase<EpiSwiglu, pg8::StaticOrder>(lds, g, S, E);
            }
            SEAM(pb + 13);
        }
        if (IN(pb + 14)) {
            PHASE_LOCALS
            for (int rep_ = 0; rep_ < (int)((DUPMASK >> 14) & 1u) + 1; ++rep_) {
            pg8::Gemm g{ACT, (const bf16_t*)(ws + W_FFN_OUT), T, D, DFF, DFF, DFF}; pg8::StaticOrder S; S.init(T, D, G, bx);
            const bool more = (l + 1 < DEPTH);
            EpiResid E{NB, 0.5f, more ? (u64*)(ws + WS_STATS) + (size_t)((l + 1) * 3 + 0) * T : nullptr};
            pg8::gemm_phase<EpiResid, pg8::StaticOrder>(lds, g, S, E);
            }
            SEAM(pb + 14);
        }
    }
    if (IN(PH_FINAL)) {
        PHASE_LOCALS
#ifdef DBG_DUMP
        for (size_t i = (size_t)bx * 512 + tid; i < (size_t)T * D; i += (size_t)G * 512) { const size_t t = i / D; const int c = (int)(i % D);
            float v = 0.f;
            if (c < 768) { const float a = __uint_as_float(((unsigned)((const bf16_t*)(ws + B_OMLA))[t * 768 + c]) << 16); v = (a - a == 0.f) ? 0.f : __builtin_ldexpf(1.0f, DBG_ENC); }
            xres[i] = v; }
#else
        for (int mrow = gw; mrow < T; mrow += ngw) rms_row_out(NB + (size_t)mrow * D, xres + (size_t)mrow * D, AIN(28), lane);
#endif
    }
#undef IN
#undef SEAM
    __syncthreads();
    if (threadIdx.x == 0) misc[5] = (__hip_atomic_fetch_add(ctl + CW_EXIT, 1u, __ATOMIC_RELAXED, __HIP_MEMORY_SCOPE_AGENT) == gridDim.x - 1u) ? 1u : 0u;
    __syncthreads();
    if (misc[5] != 0u) { for (int i = threadIdx.x; i < CTL_WORDS; i += 512) __hip_atomic_store(ctl + i, 0u, __ATOMIC_RELAXED, __HIP_MEMORY_SCOPE_AGENT); }
}

extern "C" void kernel_launch(void* const* d_in, const int* in_sizes, int n_in, void* d_out, int out_size, void* d_ws, size_t ws_size, hipStream_t stream) {
    static int grid = 0;
    if (grid == 0) {
        if (n_in != 29 || in_sizes[0] != T * D || out_size != T * D || ws_size < WS_END) {
            fprintf(stderr, "kernel_launch: unexpected shapes (n_in %d, in0 %d, out %d, ws %zu, need %zu); nothing launched\n", n_in, n_in > 0 ? in_sizes[0] : -1, out_size, ws_size, (size_t)WS_END);
            grid = -1; return; }
        int dev = 0, cus = 0, per_cu = 0;
        if (hipGetDevice(&dev) != hipSuccess || hipDeviceGetAttribute(&cus, hipDeviceAttributeMultiprocessorCount, dev) != hipSuccess) { grid = -1; return; }
        if (hipFuncSetAttribute((const void*)mk_fwd, hipFuncAttributeMaxDynamicSharedMemorySize, LDS_BYTES) != hipSuccess) { fprintf(stderr, "kernel_launch: hipFuncSetAttribute failed\n"); grid = -1; return; }
        if (hipOccupancyMaxActiveBlocksPerMultiprocessor(&per_cu, (const void*)mk_fwd, 512, LDS_BYTES) != hipSuccess || per_cu < 1)
            fprintf(stderr, "kernel_launch: occupancy query reports %d workgroups per CU\n", per_cu);
        (void)hipGetLastError();
        grid = cus;
    }
    if (grid < 0) return;
    Args a{};
    for (int i = 0; i < 29; ++i) a.in[i] = (const float*)d_in[i];
    a.out = (float*)d_out; a.ws = (unsigned char*)d_ws;
#if MK_SPLIT
#ifndef MK_LAST_PHASE
#define MK_LAST_PHASE 1000
#endif
    for (int p = 0; p < PH_TOTAL; ++p) { if (p > MK_LAST_PHASE && p != PH_FINAL) continue; a.ph_lo = p; a.ph_hi = p + 1; hipLaunchKernelGGL(mk_fwd, dim3(grid), dim3(512), LDS_BYTES, stream, a); }
#else
    a.ph_lo = 0; a.ph_hi = PH_TOTAL;
    hipLaunchKernelGGL(mk_fwd, dim3(grid), dim3(512), LDS_BYTES, stream, a);
#endif
    const hipError_t le = hipPeekAtLastError();
    if (le != hipSuccess) fprintf(stderr, "kernel_launch: launch failed: %s\n", hipGetErrorName(le));
}
```
